# Optimizing an MI355X kernel written in HIP

```python
import math
import jax
import jax.numpy as jnp
from jax import lax
import numpy as np

D_MODEL = 1024
BATCH = 8
SEQ = 2048
DEPTH = 1

GRID_W = 64
CTX_LEN = 256
N_HEADS = 8
N_KV_HEADS = 2
HEAD_DIM = 64
GROUP = N_HEADS // N_KV_HEADS
ATTN_W = N_HEADS * HEAD_DIM
KV_W = N_KV_HEADS * HEAD_DIM
WINDOW = 128
BLOCK = 128
HYENA_W = D_MODEL // 2
HYENA_ORDER = 2
FILTER_BANDS = 16
FILTER_EMB = 1 + 2 * FILTER_BANDS
FILTER_HIDDEN = 64
DECAY_TARGET = 1e-2
FAST_DECAY_PCT = 0.3
SLOW_DECAY_PCT = 1.5
ROPE_BASE = 10000.0
AXIS_ROT = HEAD_DIM // 2
N_EXPERTS = 16
EC_CAPACITY = 2
D_FF = 2048
N_BRANCHES = 2
EPS = 1e-6
NEG = -1e30

OFF_Q = 3 * HYENA_W
OFF_K = OFF_Q + ATTN_W
OFF_V = OFF_K + KV_W
OFF_G = OFF_V + KV_W
IN_W = OFF_G + N_BRANCHES * D_MODEL

kernel_name = 'hybrid_hyena_swa_ec_dit_layer'


def _rms(x, g):
    xf = x.astype(jnp.float32)
    y = xf * lax.rsqrt(jnp.mean(xf * xf, axis=-1, keepdims=True) + EPS)
    return (y * g.astype(jnp.float32)).astype(x.dtype)


def _short_conv(u, w, b):
    L = u.shape[1]
    up = jnp.pad(u, ((0, 0), (1, 1), (0, 0)))
    return up[:, :L] * w[0] + up[:, 1:L + 1] * w[1] + up[:, 2:] * w[2] + b


def _hyena_filters(L, fw1, fb1, fw2, fb2, fw3, fb3, ffreq, fout):
    f32 = jnp.float32
    t = jnp.linspace(0.0, 1.0, L, dtype=f32)[:, None]
    w = 2.0 * math.pi * jnp.arange(L, dtype=f32)[:, None] / L
    fr = jnp.linspace(1e-4, FILTER_BANDS - 1, FILTER_BANDS, dtype=f32)[None, :]
    feat = jnp.concatenate([t, jnp.cos(fr * w), -jnp.sin(fr * w)], axis=-1)
    fq = ffreq.astype(f32)
    h = jnp.sin(fq * (feat @ fw1.astype(f32) + fb1.astype(f32)))
    h = jnp.sin(fq * (h @ fw2.astype(f32) + fb2.astype(f32)))
    h = jnp.sin(fq * (h @ fw3.astype(f32) + fb3.astype(f32)))
    h = (h @ fout.astype(f32)).reshape(L, HYENA_ORDER, 2, HYENA_W)
    min_decay = math.log(DECAY_TARGET) / SLOW_DECAY_PCT
    max_decay = math.log(DECAY_TARGET) / FAST_DECAY_PCT
    deltas = jnp.linspace(min_decay, max_decay, HYENA_W, dtype=f32)
    decay = jnp.exp(-t * jnp.abs(deltas))
    h = h * decay[:, None, None, :]
    k = jnp.concatenate([h[:, :, 0], jnp.zeros((1, HYENA_ORDER, HYENA_W), f32), h[:0:-1, :, 1]], axis=0)
    return jnp.fft.rfft(k, axis=0)


def _hyena(u, conv_w, conv_b, kf, hyena_bias):
    L = u.shape[1]
    z = _short_conv(u, conv_w, conv_b)
    v, x1, x2 = jnp.split(z, 3, axis=-1)
    y = v.astype(jnp.float32)
    for o, gate in enumerate((x1, x2)):
        yf = jnp.fft.rfft(y, n=2 * L, axis=1)
        y = jnp.fft.irfft(yf * kf[:, o], n=2 * L, axis=1)[:, :L] + hyena_bias[o].astype(jnp.float32) * y
        y = gate.astype(jnp.float32) * y
    return y.astype(u.dtype)


def _axial_rope(L):
    rows = L // GRID_W
    f32 = jnp.float32
    row = jnp.repeat(jnp.arange(rows, dtype=f32), GRID_W)
    col = jnp.tile(jnp.arange(GRID_W, dtype=f32), rows)
    inv = ROPE_BASE ** (-jnp.arange(0, AXIS_ROT, 2, dtype=f32) / AXIS_ROT)
    ang = jnp.concatenate([row[:, None] * inv, col[:, None] * inv], axis=-1)
    return jnp.cos(ang)[None, :, None, :], jnp.sin(ang)[None, :, None, :]


def _rope(x, cos, sin):
    xf = x.astype(jnp.float32)
    xe, xo = xf[..., 0::2], xf[..., 1::2]
    out = jnp.stack([xe * cos - xo * sin, xe * sin + xo * cos], axis=-1).reshape(x.shape)
    return out.astype(x.dtype)


def _window_attention(q, k, v, kc, vc, sink):
    B, L = q.shape[:2]
    nb = L // BLOCK
    nw = 3 * BLOCK
    nc = kc.shape[1]
    scale = HEAD_DIM ** -0.5
    qb = q.reshape(B, nb, BLOCK, N_KV_HEADS, GROUP, HEAD_DIM)

    def bands(t):
        tp = jnp.pad(t, ((0, 0), (BLOCK, BLOCK), (0, 0), (0, 0))).reshape(B, nb + 2, BLOCK, N_KV_HEADS, HEAD_DIM)
        return jnp.concatenate([tp[:, :-2], tp[:, 1:-1], tp[:, 2:]], axis=2)

    kw, vw = bands(k), bands(v)
    s_win = jnp.einsum('bnqhgd,bnkhd->bnhgqk', qb, kw).astype(jnp.float32) * scale
    rel = jnp.arange(nw)[None, :] - BLOCK - jnp.arange(BLOCK)[:, None]
    kpos = (jnp.arange(nb)[:, None] - 1) * BLOCK + jnp.arange(nw)[None, :]
    mask = (jnp.abs(rel) <= WINDOW)[None] & ((kpos >= 0) & (kpos < L))[:, None, :]
    s_win = jnp.where(mask[None, :, None, None], s_win, NEG)
    s_ctx = jnp.einsum('bnqhgd,bchd->bnhgqc', qb, kc).astype(jnp.float32) * scale
    snk = jnp.broadcast_to(sink.astype(jnp.float32).reshape(N_KV_HEADS, GROUP)[None, None, :, :, None, None],
                           s_win.shape[:-1] + (1,))
    p = jax.nn.softmax(jnp.concatenate([s_win, s_ctx, snk], axis=-1), axis=-1)
    o = (jnp.einsum('bnhgqk,bnkhd->bnqhgd', p[..., :nw].astype(v.dtype), vw)
         + jnp.einsum('bnhgqc,bchd->bnqhgd', p[..., nw:nw + nc].astype(v.dtype), vc))
    return o.reshape(B, L, ATTN_W)


def _ctx_attention(qc, kc, vc, sink):
    B, Lc = qc.shape[:2]
    q = qc.reshape(B, Lc, N_KV_HEADS, GROUP, HEAD_DIM)
    s = jnp.einsum('bqhgd,bkhd->bhgqk', q, kc).astype(jnp.float32) * (HEAD_DIM ** -0.5)
    snk = jnp.broadcast_to(sink.astype(jnp.float32).reshape(N_KV_HEADS, GROUP)[None, :, :, None, None],
                           s.shape[:-1] + (1,))
    p = jax.nn.softmax(jnp.concatenate([s, snk], axis=-1), axis=-1)
    o = jnp.einsum('bhgqk,bkhd->bqhgd', p[..., :Lc].astype(vc.dtype), vc)
    return o.reshape(B, Lc, ATTN_W)


def _merge(y_a, y_b, gate_logits, w_branch_a, w_branch_b, w_out):
    ga, gb = jnp.split(jax.nn.sigmoid(gate_logits), 2, axis=-1)
    return (ga * (y_a @ w_branch_a) + gb * (y_b @ w_branch_b)) @ w_out


def _expert_choice(h, router, w_gate, w_up, w_down):
    B, L, D = h.shape
    cap = EC_CAPACITY * L // N_EXPERTS
    aff = jax.nn.softmax((h @ router).astype(jnp.float32), axis=-1)
    g, idx = lax.top_k(jnp.swapaxes(aff, 1, 2), cap)
    idx_flat = idx.reshape(B, N_EXPERTS * cap)
    bidx = jnp.arange(B)[:, None]
    xin = h[bidx, idx_flat].reshape(B, N_EXPERTS, cap, D)
    a = jnp.einsum('becd,edf->becf', xin, w_gate)
    b = jnp.einsum('becd,edf->becf', xin, w_up)
    y = jnp.einsum('becf,efd->becd', jax.nn.silu(a) * b, w_down)
    y = (y * g[..., None].astype(y.dtype)).reshape(B, N_EXPERTS * cap, D)
    return jnp.zeros_like(h).at[bidx, idx_flat].add(y)


def _layer(x, ctx, mod_x, mod_c, norm1, norm2, w_in, conv_w, conv_b, filt, hyena_bias,
           q_norm, k_norm, attn_sink, w_branch_a, w_branch_b, w_out, router, w_gate, w_up, w_down,
           update_ctx):
    B, L, _ = x.shape
    Lc = ctx.shape[1]
    sh1, sc1, g1, sh2, sc2, g2 = jnp.split(mod_x, 6, axis=-1)
    ch1, cc1, cg1, ch2, cc2, cg2 = jnp.split(mod_c, 6, axis=-1)

    hc = _rms(ctx, norm1) * (1 + cc1) + ch1
    if update_ctx:
        zc = hc @ w_in
        kvc = zc[..., OFF_K:OFF_G]
    else:
        kvc = hc @ w_in[:, OFF_K:OFF_G]
    kc = _rms(kvc[..., :KV_W].reshape(B, Lc, N_KV_HEADS, HEAD_DIM), k_norm)
    vc = kvc[..., KV_W:].reshape(B, Lc, N_KV_HEADS, HEAD_DIM)

    hx = _rms(x, norm1) * (1 + sc1) + sh1
    zx = hx @ w_in
    y_a = _hyena(zx[..., :OFF_Q], conv_w, conv_b, _hyena_filters(L, *filt), hyena_bias)
    cos, sin = _axial_rope(L)
    q = _rope(_rms(zx[..., OFF_Q:OFF_K].reshape(B, L, N_HEADS, HEAD_DIM), q_norm), cos, sin)
    k = _rope(_rms(zx[..., OFF_K:OFF_V].reshape(B, L, N_KV_HEADS, HEAD_DIM), k_norm), cos, sin)
    v = zx[..., OFF_V:OFF_G].reshape(B, L, N_KV_HEADS, HEAD_DIM)
    y_b = _window_attention(q, k, v, kc, vc, attn_sink)
    x_new = x + g1 * _merge(y_a, y_b, zx[..., OFF_G:], w_branch_a, w_branch_b, w_out)
    hx2 = _rms(x_new, norm2) * (1 + sc2) + sh2
    x_new = x_new + g2 * _expert_choice(hx2, router, w_gate, w_up, w_down)

    ctx_new = ctx
    if update_ctx:
        y_ac = _hyena(zc[..., :OFF_Q], conv_w, conv_b, _hyena_filters(Lc, *filt), hyena_bias)
        qc = _rms(zc[..., OFF_Q:OFF_K].reshape(B, Lc, N_HEADS, HEAD_DIM), q_norm)
        y_bc = _ctx_attention(qc, kc, vc, attn_sink)
        ctx_new = ctx + cg1 * _merge(y_ac, y_bc, zc[..., OFF_G:], w_branch_a, w_branch_b, w_out)
        hc2 = _rms(ctx_new, norm2) * (1 + cc2) + ch2
        ctx_new = ctx_new + cg2 * _expert_choice(hc2, router, w_gate, w_up, w_down)
    return x_new, ctx_new


def setup_inputs(seed: int = 0) -> dict:
    key = jax.random.key(seed)
    ks = jax.random.split(key, 32)
    f32 = jnp.float32
    D = D_MODEL

    def nrm(k, shape, scale):
        return jax.random.normal(k, shape, f32) * scale

    return {
        'x': nrm(ks[0], (BATCH, SEQ, D), 1.0),
        'c': nrm(ks[1], (BATCH, D), 1.0),
        'ctx': nrm(ks[2], (BATCH, CTX_LEN, D), 1.0),
        'c_ctx': nrm(ks[3], (D,), 1.0),
        'ada_w': nrm(ks[4], (DEPTH, D, 6 * D), 0.5 * D ** -0.5),
        'ada_b': nrm(ks[5], (DEPTH, 6 * D), 0.02),
        'norm1': 1.0 + nrm(ks[6], (DEPTH, D), 0.02),
        'norm2': 1.0 + nrm(ks[7], (DEPTH, D), 0.02),
        'w_in': nrm(ks[8], (DEPTH, D, IN_W), D ** -0.5),
        'conv_w': nrm(ks[9], (DEPTH, 3, 3 * HYENA_W), 3 ** -0.5),
        'conv_b': nrm(ks[10], (DEPTH, 3 * HYENA_W), 0.02),
        'filt_w1': nrm(ks[11], (DEPTH, FILTER_EMB, FILTER_HIDDEN), FILTER_EMB ** -0.5),
        'filt_b1': nrm(ks[12], (DEPTH, FILTER_HIDDEN), 0.02),
        'filt_w2': nrm(ks[13], (DEPTH, FILTER_HIDDEN, FILTER_HIDDEN), FILTER_HIDDEN ** -0.5),
        'filt_b2': nrm(ks[14], (DEPTH, FILTER_HIDDEN), 0.02),
        'filt_w3': nrm(ks[15], (DEPTH, FILTER_HIDDEN, FILTER_HIDDEN), FILTER_HIDDEN ** -0.5),
        'filt_b3': nrm(ks[16], (DEPTH, FILTER_HIDDEN), 0.02),
        'filt_freq': 1.0 + nrm(ks[17], (DEPTH, FILTER_HIDDEN), 0.02),
        'filt_out': nrm(ks[18], (DEPTH, FILTER_HIDDEN, HYENA_ORDER * 2 * HYENA_W), 0.05 * FILTER_HIDDEN ** -0.5),
        'hyena_bias': nrm(ks[19], (DEPTH, HYENA_ORDER, HYENA_W), 0.5),
        'q_norm': 1.0 + nrm(ks[20], (DEPTH, HEAD_DIM), 0.02),
        'k_norm': 1.0 + nrm(ks[21], (DEPTH, HEAD_DIM), 0.02),
        'attn_sink': nrm(ks[22], (DEPTH, N_HEADS), 0.5),
        'w_branch_a': nrm(ks[23], (DEPTH, HYENA_W, D), HYENA_W ** -0.5),
        'w_branch_b': nrm(ks[24], (DEPTH, ATTN_W, D), ATTN_W ** -0.5),
        'w_out': nrm(ks[25], (DEPTH, D, D), D ** -0.5),
        'router': nrm(ks[26], (DEPTH, D, N_EXPERTS), D ** -0.5),
        'w_gate': nrm(ks[27], (DEPTH, N_EXPERTS, D, D_FF), D ** -0.5),
        'w_up': nrm(ks[28], (DEPTH, N_EXPERTS, D, D_FF), D ** -0.5),
        'w_down': nrm(ks[29], (DEPTH, N_EXPERTS, D_FF, D), D_FF ** -0.5),
    }


def reference(x, c, ctx, c_ctx, ada_w, ada_b, norm1, norm2, w_in, conv_w, conv_b,
              filt_w1, filt_b1, filt_w2, filt_b2, filt_w3, filt_b3, filt_freq, filt_out,
              hyena_bias, q_norm, k_norm, attn_sink, w_branch_a, w_branch_b, w_out,
              router, w_gate, w_up, w_down):
    for l in range(DEPTH):
        mod_x = (jax.nn.silu(c) @ ada_w[l] + ada_b[l])[:, None, :]
        mod_c = (jax.nn.silu(c_ctx) @ ada_w[l] + ada_b[l])[None, None, :]
        filt = (filt_w1[l], filt_b1[l], filt_w2[l], filt_b2[l], filt_w3[l], filt_b3[l], filt_freq[l], filt_out[l])
        x, ctx = _layer(x, ctx, mod_x, mod_c, norm1[l], norm2[l], w_in[l], conv_w[l], conv_b[l], filt,
                        hyena_bias[l], q_norm[l], k_norm[l], attn_sink[l], w_branch_a[l], w_branch_b[l],
                        w_out[l], router[l], w_gate[l], w_up[l], w_down[l], l < DEPTH - 1)
    return x
```

```cpp
#include <hip/hip_runtime.h>
#include <cstdio>
#include <cstdint>

#define GAS __attribute__((address_space(1)))
#define LAS __attribute__((address_space(3)))
typedef unsigned short bf16;
typedef unsigned v4u __attribute__((ext_vector_type(4)));
typedef unsigned v2u __attribute__((ext_vector_type(2)));
typedef float f32x4 __attribute__((ext_vector_type(4)));
typedef short bf16x8 __attribute__((ext_vector_type(8)));

#ifndef MK_N_LAUNCHES
#define MK_N_LAUNCHES 11
#endif
constexpr int NPH = 11;
constexpr int N_LAUNCHES = MK_N_LAUNCHES;
constexpr int NWAVES = 8, NT = NWAVES * 64;

constexpr int D = 1024, NB = 8, L = 2048, LC = 256, M = NB * L, MC = NB * LC, MT = M + MC;
constexpr int HW = 512, QW = 512, KVW = 128, NE = 16, CAP = 256, DFF = 2048, INW = 4352;
constexpr int OFF_Q = 1536, OFF_K = 2048, OFF_V = 2176, OFF_G = 2304;
constexpr int MODW = 6 * D;
constexpr float EPS = 1e-6f;
constexpr int GT_LEN = 4096;

constexpr size_t MiB = 1u << 20;
constexpr size_t WS_CTL = 0, CTL_ZERO_BYTES = 1 * MiB;
constexpr size_t WS_MOD = 1 * MiB;
constexpr size_t WS_H3 = 1 * MiB + 512 * 1024;
constexpr size_t WS_ROPE = 2 * MiB;
constexpr size_t WS_AFF = 3 * MiB;
constexpr size_t WS_SLOT = 4 * MiB;
constexpr size_t WS_SELG = 5 * MiB;
constexpr size_t WS_GTAB = 6 * MiB;
constexpr size_t WS_WINT = 14 * MiB;
constexpr size_t WS_WAT = 23 * MiB;
constexpr size_t WS_WBT = 24 * MiB;
constexpr size_t WS_WOUTT = 25 * MiB;
constexpr size_t WS_W1T = 28 * MiB;
constexpr size_t WS_W2T = 156 * MiB;
constexpr size_t WS_R1 = 220 * MiB;
constexpr size_t WS_HX = WS_R1;
constexpr size_t WS_ZT = WS_R1 + 36 * MiB;
constexpr size_t WS_QRAW = WS_R1 + 84 * MiB;
constexpr size_t WS_KRAW = WS_R1 + 100 * MiB;
constexpr size_t WS_VB = WS_R1 + 104 * MiB;
constexpr size_t WS_KC = WS_R1 + 108 * MiB;
constexpr size_t WS_VC = WS_R1 + 108 * MiB + 512 * 1024;
constexpr size_t WS_TA = WS_R1;
constexpr size_t WS_MM = WS_R1 + 32 * MiB;
constexpr size_t WS_HB = WS_R1;
constexpr size_t WS_R2 = 348 * MiB;
constexpr size_t WS_GA = WS_R2, WS_GB = WS_R2 + 32 * MiB;
constexpr size_t WS_XIN = WS_R2;
constexpr size_t WS_YBUF = WS_R2;
constexpr size_t WS_R3 = 412 * MiB;
constexpr size_t WS_YA = WS_R3, WS_YB = WS_R3 + 16 * MiB;
constexpr size_t WS_HX2 = WS_R3;
constexpr size_t WS_END = 444 * MiB;

constexpr int CW_BAR = 4096;
constexpr int LDS_BYTES = 147456;
constexpr int MISC_OFF = 131072 + 320;

__device__ __forceinline__ unsigned f2bf(float f) { unsigned u = __builtin_bit_cast(unsigned, f); return (u + 0x7fffu + ((u >> 16) & 1u)) >> 16; }
__device__ __forceinline__ unsigned pk2(float lo, float hi) { return f2bf(lo) | (f2bf(hi) << 16); }
__device__ __forceinline__ float bf2f(unsigned b) { return __builtin_bit_cast(float, b << 16); }
__device__ __forceinline__ float bflo(unsigned w) { return __builtin_bit_cast(float, w << 16); }
__device__ __forceinline__ float bfhi(unsigned w) { return __builtin_bit_cast(float, w & 0xffff0000u); }
__device__ __forceinline__ float rbf(float f) { return bf2f(f2bf(f)); }
__device__ __forceinline__ void unpack8(v4u w, float* o) { o[0] = bflo(w.x); o[1] = bfhi(w.x); o[2] = bflo(w.y); o[3] = bfhi(w.y); o[4] = bflo(w.z); o[5] = bfhi(w.z); o[6] = bflo(w.w); o[7] = bfhi(w.w); }
__device__ __forceinline__ v4u pack8(const float* v) { v4u w; w.x = pk2(v[0], v[1]); w.y = pk2(v[2], v[3]); w.z = pk2(v[4], v[5]); w.w = pk2(v[6], v[7]); return w; }
__device__ __forceinline__ float siluf(float x) { return x / (1.f + __expf(-x)); }
__device__ __forceinline__ float sigmf(float x) { return 1.f / (1.f + __expf(-x)); }
__device__ __forceinline__ float wave_sum(float v) {
#pragma unroll
    for (int o = 1; o < 64; o <<= 1) v += __shfl_xor(v, o);
    return v;
}
#define LDS_WAIT() asm volatile("s_waitcnt lgkmcnt(0)" ::: "memory")

#define XB_TMO      128
#define XB_XCNT(j)  (256  + 64 * (j))
#define XB_XSUB(j)  (1280 + 64 * (j))
#define XB_XGEN(j)  (2304 + 64 * (j))
#define XB_TOP      3328
#define XB_TOPGEN   3392
#define XCD_BAR_WORDS 3456
#define XB_SPIN_CAP (1u << 25)
__device__ __forceinline__ unsigned xb_ld(unsigned* p)              { return __hip_atomic_load(p, __ATOMIC_RELAXED, __HIP_MEMORY_SCOPE_AGENT); }
__device__ __forceinline__ unsigned xb_add(unsigned* p, unsigned v) { return __hip_atomic_fetch_add(p, v, __ATOMIC_RELAXED, __HIP_MEMORY_SCOPE_AGENT); }
__device__ __forceinline__ unsigned xb_xcc_id() { return (unsigned)__builtin_amdgcn_s_getreg((3 << 11) | 20) & 0xFu; }
#define XB_SPIN(cond, bar) do { unsigned _sp = 0; while (cond) { __builtin_amdgcn_s_sleep(1); \
    if ((++_sp & 255u) == 0u) { if (xb_ld(&(bar)[XB_TMO])) break; if (_sp > XB_SPIN_CAP) { atomicAdd(&(bar)[XB_TMO], 1u); break; } } } } while (0)
struct XcdBarrier { unsigned* bar; unsigned x; volatile LAS unsigned* st; };
__device__ __forceinline__ XcdBarrier xcd_barrier_post(unsigned* bar, volatile LAS unsigned* st) {
    XcdBarrier b; b.bar = bar; b.x = xb_xcc_id(); b.st = st;
    if (threadIdx.x == 0) (void)xb_add(&bar[XB_XCNT(b.x)], 1u);
    return b;
}
__device__ __forceinline__ void xcd_barrier_complete(unsigned* bar, unsigned x, unsigned& nloc, unsigned& nx) {
    const unsigned G = gridDim.x * gridDim.y * gridDim.z;
    unsigned sum, cnt, mine, sp = 0u;
    for (;;) {
        sum = 0u; cnt = 0u; mine = 0u;
#pragma unroll
        for (unsigned j = 0; j < 16; ++j) { const unsigned c = xb_ld(&bar[XB_XCNT(j)]); sum += c; cnt += (c > 0u) ? 1u : 0u; mine = (j == x) ? c : mine; }
        if (sum == G) break;
        __builtin_amdgcn_s_sleep(1);
        if ((++sp & 255u) == 0u) { if (xb_ld(&bar[XB_TMO])) break; if (sp > XB_SPIN_CAP) { atomicAdd(&bar[XB_TMO], 1u); break; } }
    }
    nloc = mine > 0u ? mine : 1u; nx = cnt > 0u ? cnt : 1u;
}
__device__ __forceinline__ void xcd_barrier(const XcdBarrier& b) {
    asm volatile("s_waitcnt vmcnt(0)" ::: "memory");
    __syncthreads();
    if (threadIdx.x == 0) {
        unsigned* bar = b.bar;
        __builtin_amdgcn_s_waitcnt(0);
        unsigned nloc = b.st[0], nx = b.st[1];
        if (nloc == 0u) { xcd_barrier_complete(bar, b.x, nloc, nx); b.st[0] = nloc; b.st[1] = nx; }
        const unsigned old = xb_add(&bar[XB_XSUB(b.x)], 1u);
        const unsigned gen = old / nloc;
        if (old + 1u == (gen + 1u) * nloc) {
            __builtin_amdgcn_fence(__ATOMIC_RELEASE, "agent");
            asm volatile("s_waitcnt vmcnt(0)" ::: "memory");
            const unsigned og = xb_add(&bar[XB_TOP], 1u);
            const unsigned tg = og / nx;
            if (og + 1u == (tg + 1u) * nx) xb_add(&bar[XB_TOPGEN], 1u);
            else XB_SPIN(xb_ld(&bar[XB_TOPGEN]) == tg, bar);
            __builtin_amdgcn_fence(__ATOMIC_ACQUIRE, "agent");
            xb_add(&bar[XB_XGEN(b.x)], 1u);
            asm volatile("s_waitcnt vmcnt(0)" ::: "memory");
        } else {
            XB_SPIN(xb_ld(&bar[XB_XGEN(b.x)]) == gen, bar);
            __builtin_amdgcn_fence(__ATOMIC_ACQUIRE, "agent");
            asm volatile("s_waitcnt vmcnt(0)" ::: "memory");
        }
    }
    __syncthreads();
}

struct Args { const float* in[30]; float* out; unsigned char* ws; int ph_lo, ph_hi, li, pad; };
struct Ctx {
    LAS unsigned char* lds; int tid, lane, wave, bid, nb;
    const float* in[30]; float* out; unsigned char* ws;
};
#define IN_X 0
#define IN_C 1
#define IN_CTX 2
#define IN_CCTX 3
#define IN_ADAW 4
#define IN_ADAB 5
#define IN_NORM1 6
#define IN_NORM2 7
#define IN_WIN 8
#define IN_CONVW 9
#define IN_CONVB 10
#define IN_FW1 11
#define IN_FB1 12
#define IN_FW2 13
#define IN_FB2 14
#define IN_FW3 15
#define IN_FB3 16
#define IN_FFREQ 17
#define IN_FOUT 18
#define IN_HBIAS 19
#define IN_QNORM 20
#define IN_KNORM 21
#define IN_SINK 22
#define IN_WA 23
#define IN_WB 24
#define IN_WOUT 25
#define IN_ROUTER 26
#define IN_WGATE 27
#define IN_WUP 28
#define IN_WDOWN 29

template <class Epi, class Units>
__device__ __forceinline__ void gemm_naive(const Ctx& C, int K, int lda, int ldb, const Units& U, const Epi& E) {
    LAS float* As = (LAS float*)C.lds;
    LAS float* Bs = As + 32 * 132;
    const int tid = C.tid, ty = tid >> 4, tx = tid & 15;
    for (int idx = C.bid;; idx += C.nb) {
        int pm, pn; const bf16* Ab; const bf16* Bb;
        if (!U.get(idx, pm, pn, Ab, Bb)) break;
        for (int half = 0; half < 2; ++half) {
            float acc[4][16];
#pragma unroll
            for (int r = 0; r < 4; ++r)
#pragma unroll
                for (int j = 0; j < 16; ++j) acc[r][j] = 0.f;
            for (int k0 = 0; k0 < K; k0 += 32) {
                {
                    const int row = tid >> 2, kc = tid & 3;
                    const v4u w = *(const v4u*)(Ab + (size_t)(half * 128 + row) * lda + k0 + kc * 8);
                    float f[8]; unpack8(w, f);
#pragma unroll
                    for (int j = 0; j < 8; ++j) As[(kc * 8 + j) * 132 + row] = f[j];
                }
#pragma unroll
                for (int i = 0; i < 2; ++i) {
                    const int c = tid + 512 * i, row = c >> 2, kc = c & 3;
                    const v4u w = *(const v4u*)(Bb + (size_t)row * ldb + k0 + kc * 8);
                    float f[8]; unpack8(w, f);
#pragma unroll
                    for (int j = 0; j < 8; ++j) Bs[(kc * 8 + j) * 260 + row] = f[j];
                }
                __syncthreads();
#pragma unroll 4
                for (int k = 0; k < 32; ++k) {
                    const f32x4 a = *(const LAS f32x4*)(As + k * 132 + ty * 4);
                    const f32x4 b0 = *(const LAS f32x4*)(Bs + k * 260 + tx * 8), b1 = *(const LAS f32x4*)(Bs + k * 260 + tx * 8 + 4);
                    const f32x4 b2 = *(const LAS f32x4*)(Bs + k * 260 + 128 + tx * 8), b3 = *(const LAS f32x4*)(Bs + k * 260 + 128 + tx * 8 + 4);
#pragma unroll
                    for (int r = 0; r < 4; ++r) {
#pragma unroll
                        for (int j = 0; j < 4; ++j) { acc[r][j] += a[r] * b0[j]; acc[r][4 + j] += a[r] * b1[j]; acc[r][8 + j] += a[r] * b2[j]; acc[r][12 + j] += a[r] * b3[j]; }
                    }
                }
                __syncthreads();
            }
#pragma unroll
            for (int r = 0; r < 4; ++r) E(pm * 256 + half * 128 + ty * 4 + r, pn, tx * 8, &acc[r][0], &acc[r][8]);
        }
    }
}

struct UnitsStd {
    const bf16* A; const bf16* Bt; int lda, ldb, nM, nN; size_t bgroup;
    __device__ __forceinline__ bool get(int idx, int& pm, int& pn, const bf16*& Ab, const bf16*& Bb) const {
        if (idx >= nM * nN) return false;
        pm = idx / nN; pn = idx % nN;
        Ab = A + (size_t)pm * 256 * lda; Bb = Bt + (size_t)(pm >> 3) * bgroup + (size_t)pn * 256 * ldb; return true;
    }
};
struct UnitsIn {
    const bf16* A; const bf16* Bt;
    __device__ __forceinline__ bool get(int idx, int& pm, int& pn, const bf16*& Ab, const bf16*& Bb) const {
        if (idx < 64 * 11) { pm = idx / 11; pn = idx % 11; }
        else if (idx < 64 * 11 + 8) { pm = 64 + (idx - 64 * 11); pn = 2; }
        else return false;
        Ab = A + (size_t)pm * 256 * D; Bb = Bt + (size_t)pn * 256 * D; return true;
    }
};

struct EpiZ {
    bf16* ZT;
    __device__ __forceinline__ void st(int ch, int tok, const float* v) const { *(v4u*)(ZT + ((size_t)((tok >> 11) * 1536 + ch)) * 2048 + (tok & 2047)) = pack8(v); }
    __device__ __forceinline__ void operator()(int row, int pn, int c8, const float* v0, const float* v1) const { st(row, pn * 256 + c8, v0); st(row, pn * 256 + 128 + c8, v1); }
};
struct EpiIn {
    bf16 *Q, *Kr, *V, *KC, *VC, *GA, *GB;
    __device__ __forceinline__ void one(int row, int n, const float* v) const {
        if (n < OFF_K) { if (row < M) *(v4u*)(Q + (size_t)row * QW + (n - OFF_Q)) = pack8(v); }
        else if (n < OFF_V) { if (row < M) *(v4u*)(Kr + (size_t)row * KVW + (n - OFF_K)) = pack8(v); else *(v4u*)(KC + (size_t)(row - M) * KVW + (n - OFF_K)) = pack8(v); }
        else if (n < OFF_G) { if (row < M) *(v4u*)(V + (size_t)row * KVW + (n - OFF_V)) = pack8(v); else *(v4u*)(VC + (size_t)(row - M) * KVW + (n - OFF_V)) = pack8(v); }
        else if (row < M) {
            float s[8];
#pragma unroll
            for (int j = 0; j < 8; ++j) s[j] = sigmf(v[j]);
            if (n < OFF_G + D) *(v4u*)(GA + (size_t)row * D + (n - OFF_G)) = pack8(s); else *(v4u*)(GB + (size_t)row * D + (n - OFF_G - D)) = pack8(s);
        }
    }
    __device__ __forceinline__ void operator()(int row, int pn, int c8, const float* v0, const float* v1) const { one(row, OFF_Q + pn * 256 + c8, v0); one(row, OFF_Q + pn * 256 + 128 + c8, v1); }
};
struct EpiT1 {
    const bf16* GA; bf16* TA;
    __device__ __forceinline__ void one(int row, int n, const float* v) const {
        float g[8], o[8]; unpack8(*(const v4u*)(GA + (size_t)row * D + n), g);
#pragma unroll
        for (int j = 0; j < 8; ++j) o[j] = g[j] * v[j];
        *(v4u*)(TA + (size_t)row * D + n) = pack8(o);
    }
    __device__ __forceinline__ void operator()(int row, int pn, int c8, const float* v0, const float* v1) const { one(row, pn * 256 + c8, v0); one(row, pn * 256 + 128 + c8, v1); }
};
struct EpiT2 {
    const bf16* GB; const bf16* TA; bf16* MMo;
    __device__ __forceinline__ void one(int row, int n, const float* v) const {
        float g[8], t[8], o[8]; unpack8(*(const v4u*)(GB + (size_t)row * D + n), g); unpack8(*(const v4u*)(TA + (size_t)row * D + n), t);
#pragma unroll
        for (int j = 0; j < 8; ++j) o[j] = t[j] + g[j] * v[j];
        *(v4u*)(MMo + (size_t)row * D + n) = pack8(o);
    }
    __device__ __forceinline__ void operator()(int row, int pn, int c8, const float* v0, const float* v1) const { one(row, pn * 256 + c8, v0); one(row, pn * 256 + 128 + c8, v1); }
};
struct EpiOut {
    const float* x; const float* mod; float* out;
    __device__ __forceinline__ void one(int row, int n, const float* v) const {
        const float* g1 = mod + (size_t)(row >> 11) * MODW + 2 * D + n; const float* xr = x + (size_t)row * D + n; float* o = out + (size_t)row * D + n;
        const f32x4 x0 = *(const f32x4*)xr, x1 = *(const f32x4*)(xr + 4), ga = *(const f32x4*)g1, gb = *(const f32x4*)(g1 + 4);
        f32x4 o0, o1;
#pragma unroll
        for (int j = 0; j < 4; ++j) { o0[j] = x0[j] + ga[j] * v[j]; o1[j] = x1[j] + gb[j] * v[4 + j]; }
        *(f32x4*)o = o0; *(f32x4*)(o + 4) = o1;
    }
    __device__ __forceinline__ void operator()(int row, int pn, int c8, const float* v0, const float* v1) const { one(row, pn * 256 + c8, v0); one(row, pn * 256 + 128 + c8, v1); }
};
struct EpiH {
    bf16* HB;
    __device__ __forceinline__ void operator()(int row, int pn, int c8, const float* v0, const float* v1) const {
        float o[8];
#pragma unroll
        for (int j = 0; j < 8; ++j) o[j] = siluf(v0[j]) * v1[j];
        *(v4u*)(HB + (size_t)row * DFF + pn * 128 + c8) = pack8(o);
    }
};
struct EpiY {
    const float* selg; const float* mod; bf16* Y;
    __device__ __forceinline__ void one(int row, int n, const float* v) const {
        const float g = selg[row]; const float* g2 = mod + (size_t)((row >> 8) & 7) * MODW + 5 * D + n; float o[8];
#pragma unroll
        for (int j = 0; j < 8; ++j) o[j] = v[j] * g * g2[j];
        *(v4u*)(Y + (size_t)row * D + n) = pack8(o);
    }
    __device__ __forceinline__ void operator()(int row, int pn, int c8, const float* v0, const float* v1) const { one(row, pn * 256 + c8, v0); one(row, pn * 256 + 128 + c8, v1); }
};

__device__ __forceinline__ void transpose_item(const float* W, int K, int N, bf16* WT, int ldt, int k0, int n0, int drow0, LAS float* scr, int lane) {
#pragma unroll 8
    for (int i = 0; i < 32; ++i) { const int kk = 2 * i + (lane >> 5); scr[kk * 33 + (lane & 31)] = W[(size_t)(k0 + kk) * N + n0 + (lane & 31)]; }
    LDS_WAIT(); asm volatile("" ::: "memory");
    const int c = lane & 7;
#pragma unroll
    for (int j = 0; j < 4; ++j) { const int n = (lane >> 3) + 8 * j; const LAS float* s = scr + (8 * c) * 33 + n;
        v4u o; o.x = pk2(s[0 * 33], s[1 * 33]); o.y = pk2(s[2 * 33], s[3 * 33]); o.z = pk2(s[4 * 33], s[5 * 33]); o.w = pk2(s[6 * 33], s[7 * 33]);
        *(v4u*)(WT + (size_t)(drow0 + n) * ldt + k0 + 8 * c) = o; }
    LDS_WAIT(); asm volatile("" ::: "memory");
}
__device__ __forceinline__ void p0_phase(const Ctx& C) {
    const int gw = C.bid * NWAVES + C.wave, NGW = C.nb * NWAVES, lane = C.lane;
    float* mod = (float*)(C.ws + WS_MOD);
    {
        LAS float* sc = (LAS float*)C.lds;
        LAS float* red = sc + 9 * 1024;
        for (int i = C.tid; i < 9 * 1024; i += NT) { const float v = (i < 8 * 1024) ? C.in[IN_C][i] : C.in[IN_CCTX][i - 8 * 1024]; sc[i] = siluf(v); }
        __syncthreads();
        for (int cb = C.bid; cb < MODW / 32; cb += C.nb) {
            const int cl = C.tid & 31, kg = C.tid >> 5, n = cb * 32 + cl;
            float a[9];
#pragma unroll
            for (int r = 0; r < 9; ++r) a[r] = 0.f;
            for (int k = kg; k < D; k += 16) { const float w = C.in[IN_ADAW][(size_t)k * MODW + n];
#pragma unroll
                for (int r = 0; r < 9; ++r) a[r] += sc[r * 1024 + k] * w; }
#pragma unroll
            for (int r = 0; r < 9; ++r) red[(kg * 9 + r) * 32 + cl] = a[r];
            __syncthreads();
            if (C.tid < 9 * 32) { const int r = C.tid >> 5, c2 = C.tid & 31; float s = 0.f;
                for (int g = 0; g < 16; ++g) s += red[(g * 9 + r) * 32 + c2];
                mod[(size_t)r * MODW + cb * 32 + c2] = s + C.in[IN_ADAB][cb * 32 + c2]; }
            __syncthreads();
        }
    }
    {
        float* H3 = (float*)(C.ws + WS_H3);
        const double PI2 = 6.283185307179586476925286766559;
        for (int pos = gw; pos < L; pos += NGW) {
            double feat = 0.0;
            {
                const double t = (double)pos / (double)(L - 1), w = PI2 * (double)pos / (double)L;
                if (lane == 0) feat = t;
                else if (lane <= 32) { const int b = (lane - 1) & 15; const double fr = 1e-4 + (15.0 - 1e-4) * (double)b / 15.0; feat = (lane <= 16) ? cos(fr * w) : -sin(fr * w); }
            }
            const double fq = (double)C.in[IN_FFREQ][lane];
            double acc = (double)C.in[IN_FB1][lane];
            for (int k = 0; k < 33; ++k) acc += __shfl(feat, k) * (double)C.in[IN_FW1][k * 64 + lane];
            double h = sin(fq * acc);
            acc = (double)C.in[IN_FB2][lane];
            for (int k = 0; k < 64; ++k) acc += __shfl(h, k) * (double)C.in[IN_FW2][k * 64 + lane];
            h = sin(fq * acc);
            acc = (double)C.in[IN_FB3][lane];
            for (int k = 0; k < 64; ++k) acc += __shfl(h, k) * (double)C.in[IN_FW3][k * 64 + lane];
            h = sin(fq * acc);
            H3[(size_t)pos * 64 + lane] = (float)h;
        }
    }
    {
        float* R = (float*)(C.ws + WS_ROPE);
        for (int i = C.bid * NT + C.tid; i < L * 32; i += C.nb * NT) {
            const int pos = i >> 5, a = i & 31; const int m = a & 15;
            const double inv = pow(10000.0, -(double)m / 16.0);
            const double p = (a < 16) ? (double)(pos >> 6) : (double)(pos & 63);
            const double ang = p * inv;
            R[2 * i] = (float)cos(ang); R[2 * i + 1] = (float)sin(ang);
        }
    }
    {
        LAS float* scr = (LAS float*)(C.lds + C.wave * 16384);
        __syncthreads();
        bf16* WINT = (bf16*)(C.ws + WS_WINT); bf16* WAT = (bf16*)(C.ws + WS_WAT); bf16* WBT = (bf16*)(C.ws + WS_WBT); bf16* WOT = (bf16*)(C.ws + WS_WOUTT);
        bf16* W1T = (bf16*)(C.ws + WS_W1T); bf16* W2T = (bf16*)(C.ws + WS_W2T);
        constexpr int I_IN = (D / 64) * (INW / 32), I_A = (HW / 64) * (D / 32), I_O = (D / 64) * (D / 32), I_G = (D / 64) * (DFF / 32), I_D = (DFF / 64) * (D / 32);
        constexpr int NITEMS = I_IN + 2 * I_A + I_O + NE * (2 * I_G + I_D);
        for (int it = gw; it < NITEMS; it += NGW) {
            int r = it;
            if (r < I_IN) { const int nblk = INW / 32, kb = r / nblk, nbk = r % nblk; transpose_item(C.in[IN_WIN], D, INW, WINT, D, kb * 64, nbk * 32, nbk * 32, scr, lane); continue; } r -= I_IN;
            if (r < I_A) { const int nblk = D / 32, kb = r / nblk, nbk = r % nblk; transpose_item(C.in[IN_WA], HW, D, WAT, HW, kb * 64, nbk * 32, nbk * 32, scr, lane); continue; } r -= I_A;
            if (r < I_A) { const int nblk = D / 32, kb = r / nblk, nbk = r % nblk; transpose_item(C.in[IN_WB], HW, D, WBT, HW, kb * 64, nbk * 32, nbk * 32, scr, lane); continue; } r -= I_A;
            if (r < I_O) { const int nblk = D / 32, kb = r / nblk, nbk = r % nblk; transpose_item(C.in[IN_WOUT], D, D, WOT, D, kb * 64, nbk * 32, nbk * 32, scr, lane); continue; } r -= I_O;
            const int e = r / (2 * I_G + I_D); r -= e * (2 * I_G + I_D);
            if (r < 2 * I_G) { const int which = r / I_G; r -= which * I_G; const int nblk = DFF / 32, kb = r / nblk, nbk = r % nblk, f0 = nbk * 32;
                const float* W = (which ? C.in[IN_WUP] : C.in[IN_WGATE]) + (size_t)e * D * DFF;
                const int drow0 = e * 4096 + 256 * (f0 >> 7) + 128 * which + (f0 & 127);
                transpose_item(W, D, DFF, W1T, D, kb * 64, f0, drow0, scr, lane); continue; }
            r -= 2 * I_G;
            { const int nblk = D / 32, kb = r / nblk, nbk = r % nblk; transpose_item(C.in[IN_WDOWN] + (size_t)e * DFF * D, DFF, D, W2T, DFF, kb * 64, nbk * 32, e * 1024 + nbk * 32, scr, lane); }
        }
    }
}

__device__ __forceinline__ void p1_phase(const Ctx& C) {
    const int gw = C.bid * NWAVES + C.wave, NGW = C.nb * NWAVES, lane = C.lane;
    const float* mod = (const float*)(C.ws + WS_MOD);
    bf16* HX = (bf16*)(C.ws + WS_HX);
    for (int row = gw; row < MT; row += NGW) {
        const float* xr = (row < M) ? C.in[IN_X] + (size_t)row * D : C.in[IN_CTX] + (size_t)(row - M) * D;
        const int mb = (row < M) ? (row >> 11) : 8;
        const float* sh = mod + (size_t)mb * MODW; const float* sc = sh + D;
        f32x4 v[4]; float s = 0.f;
#pragma unroll
        for (int j = 0; j < 4; ++j) { v[j] = *(const f32x4*)(xr + 4 * lane + 256 * j); s += (v[j][0] * v[j][0] + v[j][1] * v[j][1]) + (v[j][2] * v[j][2] + v[j][3] * v[j][3]); }
        const float rstd = 1.f / sqrtf(wave_sum(s) * (1.f / D) + EPS);
#pragma unroll
        for (int j = 0; j < 4; ++j) {
            const int c0 = 4 * lane + 256 * j; const f32x4 g = *(const f32x4*)(C.in[IN_NORM1] + c0), a = *(const f32x4*)(sc + c0), b = *(const f32x4*)(sh + c0);
            float o[4];
#pragma unroll
            for (int i = 0; i < 4; ++i) o[i] = v[j][i] * rstd * g[i] * (1.f + a[i]) + b[i];
            v2u w; w.x = pk2(o[0], o[1]); w.y = pk2(o[2], o[3]);
            *(v2u*)(HX + (size_t)row * D + c0) = w;
        }
    }
    {
        const float* H3 = (const float*)(C.ws + WS_H3); bf16* GT = (bf16*)(C.ws + WS_GTAB);
        LAS float* fo = (LAS float*)C.lds;
        const float min_decay = -3.0701134573253946f, max_decay = -15.350567286626973f;
        for (int c = C.bid; c < HW; c += C.nb) {
            __syncthreads();
            if (C.tid < 256) { const int q = C.tid >> 6, k = C.tid & 63; fo[C.tid] = C.in[IN_FOUT][(size_t)k * 2048 + q * 512 + c]; }
            __syncthreads();
            const float delta = fabsf(min_decay + (max_decay - min_decay) * (float)c / 511.f);
#pragma unroll 1
            for (int kk = 0; kk < 4; ++kk) {
                const int t = C.tid + 512 * kk; float a[4] = {0.f, 0.f, 0.f, 0.f};
                const float* hr = H3 + (size_t)t * 64;
#pragma unroll 2
                for (int k = 0; k < 64; k += 4) { const f32x4 h = *(const f32x4*)(hr + k);
#pragma unroll
                    for (int i = 0; i < 4; ++i) {
#pragma unroll
                        for (int q = 0; q < 4; ++q) a[q] += h[i] * fo[q * 64 + k + i]; } }
                const float dec = expf(-((float)t / (float)(L - 1)) * delta);
#pragma unroll
                for (int o = 0; o < 2; ++o) {
                    float f = a[o * 2] * dec, bk = a[o * 2 + 1] * dec;
                    if (t == 0) { f += C.in[IN_HBIAS][o * 512 + c]; bk = 0.f; }
                    bf16* g = GT + ((size_t)c * 2 + o) * GT_LEN;
                    g[2048 + t] = (bf16)f2bf(f); if (t == 0) g[0] = (bf16)0; else g[2048 - t] = (bf16)f2bf(bk);
                }
            }
        }
    }
}

__device__ __forceinline__ float conv3(const bf16* u, int t, float w0, float w1, float w2, float cb) {
    const float a = (t > 0) ? bf2f(u[t - 1]) : 0.f, b = bf2f(u[t]), c = (t < L - 1) ? bf2f(u[t + 1]) : 0.f;
    return a * w0 + b * w1 + c * w2 + cb;
}
__device__ __forceinline__ void hyena_naive(const Ctx& C, int c) {
    const bf16* ZT = (const bf16*)(C.ws + WS_ZT); const bf16* GT = (const bf16*)(C.ws + WS_GTAB); bf16* YA = (bf16*)(C.ws + WS_YA);
    LAS float* G = (LAS float*)C.lds;
    LAS bf16* y0 = (LAS bf16*)(G + 4096);
    LAS bf16* y1 = y0 + 8 * 2048;
    const float* cw = C.in[IN_CONVW]; const float* cb = C.in[IN_CONVB];
    __syncthreads();
    for (int i = C.tid; i < 8 * 2048; i += NT) { const int b = i >> 11, t = i & 2047;
        y0[i] = (bf16)f2bf(conv3(ZT + ((size_t)b * 1536 + c) * 2048, t, cw[c], cw[1536 + c], cw[3072 + c], cb[c])); }
    for (int o = 0; o < 2; ++o) {
        LAS bf16* yi = o ? y1 : y0;
        for (int i = C.tid; i < 4096; i += NT) G[i] = bf2f(GT[((size_t)c * 2 + o) * GT_LEN + i]);
        __syncthreads();
        const int gc = 512 * (o + 1) + c;
        float acc[4][8];
#pragma unroll
        for (int k = 0; k < 4; ++k)
#pragma unroll
            for (int b = 0; b < 8; ++b) acc[k][b] = 0.f;
        for (int s = 0; s < L; ++s) {
            float yv[8];
#pragma unroll
            for (int b = 0; b < 8; ++b) yv[b] = bf2f(yi[b * 2048 + s]);
#pragma unroll
            for (int k = 0; k < 4; ++k) { const float g = G[2048 + C.tid + 512 * k - s];
#pragma unroll
                for (int b = 0; b < 8; ++b) acc[k][b] += g * yv[b]; }
        }
#pragma unroll
        for (int k = 0; k < 4; ++k)
#pragma unroll
            for (int b = 0; b < 8; ++b) { const int t = C.tid + 512 * k;
                const float gate = conv3(ZT + ((size_t)b * 1536 + gc) * 2048, t, cw[gc], cw[1536 + gc], cw[3072 + gc], cb[gc]);
                const float r = gate * acc[k][b];
                if (o == 0) y1[b * 2048 + t] = (bf16)f2bf(r); else YA[((size_t)b * 2048 + t) * HW + c] = (bf16)f2bf(r); }
        __syncthreads();
    }
}

__device__ __forceinline__ void attn_naive(const Ctx& C, int item) {
    const int b = item >> 5, kvh = (item >> 4) & 1, qb = item & 15;
    const bf16* Q = (const bf16*)(C.ws + WS_QRAW); const bf16* Kr = (const bf16*)(C.ws + WS_KRAW); const bf16* V = (const bf16*)(C.ws + WS_VB);
    const bf16* KC = (const bf16*)(C.ws + WS_KC); const bf16* VC = (const bf16*)(C.ws + WS_VC); bf16* YB = (bf16*)(C.ws + WS_YB);
    const float* rope = (const float*)(C.ws + WS_ROPE);
    LAS float* Ks = (LAS float*)C.lds;
    LAS float* Vs = Ks + 128 * 64;
    const int g = C.tid >> 7, qi = C.tid & 127, h = kvh * 4 + g, t = qb * 128 + qi;
    float q[64];
    {
        const bf16* qr = Q + ((size_t)b * L + t) * QW + h * 64; float ss = 0.f;
#pragma unroll
        for (int j = 0; j < 8; ++j) { unpack8(*(const v4u*)(qr + 8 * j), q + 8 * j); }
#pragma unroll
        for (int d = 0; d < 64; ++d) ss += q[d] * q[d];
        const float rs = 1.f / sqrtf(ss * (1.f / 64.f) + EPS);
#pragma unroll
        for (int i = 0; i < 32; ++i) { const float cs = rope[((size_t)t * 32 + i) * 2], sn = rope[((size_t)t * 32 + i) * 2 + 1];
            const float xe = q[2 * i] * rs * C.in[IN_QNORM][2 * i], xo = q[2 * i + 1] * rs * C.in[IN_QNORM][2 * i + 1];
            q[2 * i] = rbf((xe * cs - xo * sn) * 0.125f); q[2 * i + 1] = rbf((xe * sn + xo * cs) * 0.125f); }
    }
    float mrun = -1e30f, lrun = 0.f, o[64];
#pragma unroll
    for (int d = 0; d < 64; ++d) o[d] = 0.f;
    for (int ch = 0; ch < 5; ++ch) {
        const int kblk = qb - 1 + ch;
        if (ch < 3 && (kblk < 0 || kblk >= 16)) continue;
        __syncthreads();
        {
            const int key = C.tid >> 2, part = C.tid & 3;
            const bf16* kr; const bf16* vr; int pos = 0;
            if (ch < 3) { pos = kblk * 128 + key; kr = Kr + ((size_t)b * L + pos) * KVW + kvh * 64 + part * 16; vr = V + ((size_t)b * L + pos) * KVW + kvh * 64 + part * 16; }
            else { const int cp = (ch - 3) * 128 + key; kr = KC + ((size_t)b * LC + cp) * KVW + kvh * 64 + part * 16; vr = VC + ((size_t)b * LC + cp) * KVW + kvh * 64 + part * 16; }
            float kf[16], vf[16];
            unpack8(*(const v4u*)kr, kf); unpack8(*(const v4u*)(kr + 8), kf + 8); unpack8(*(const v4u*)vr, vf); unpack8(*(const v4u*)(vr + 8), vf + 8);
            float ss = 0.f;
#pragma unroll
            for (int d = 0; d < 16; ++d) ss += kf[d] * kf[d];
            ss += __shfl_xor(ss, 1); ss += __shfl_xor(ss, 2);
            const float rs = 1.f / sqrtf(ss * (1.f / 64.f) + EPS);
#pragma unroll
            for (int i = 0; i < 8; ++i) {
                const int pi = part * 8 + i;
                float xe = kf[2 * i] * rs * C.in[IN_KNORM][2 * pi], xo = kf[2 * i + 1] * rs * C.in[IN_KNORM][2 * pi + 1];
                if (ch < 3) { const float cs = rope[((size_t)pos * 32 + pi) * 2], sn = rope[((size_t)pos * 32 + pi) * 2 + 1]; const float a = xe * cs - xo * sn, bb = xe * sn + xo * cs; xe = a; xo = bb; }
                Ks[key * 64 + part * 16 + 2 * i] = rbf(xe); Ks[key * 64 + part * 16 + 2 * i + 1] = rbf(xo);
            }
#pragma unroll
            for (int d = 0; d < 16; ++d) Vs[key * 64 + part * 16 + d] = vf[d];
        }
        __syncthreads();
        for (int key = 0; key < 128; ++key) {
            if (ch < 3) { const int s = kblk * 128 + key; const int df = t - s; if (df > 128 || df < -128) continue; }
            float sc = 0.f;
#pragma unroll
            for (int d = 0; d < 64; ++d) sc += q[d] * Ks[key * 64 + d];
            const float mn = fmaxf(mrun, sc), al = __expf(mrun - mn), p = __expf(sc - mn);
            lrun = lrun * al + p; mrun = mn;
#pragma unroll
            for (int d = 0; d < 64; ++d) o[d] = o[d] * al + p * Vs[key * 64 + d];
        }
    }
    {
        const float sk = C.in[IN_SINK][h]; const float mn = fmaxf(mrun, sk), al = __expf(mrun - mn);
        lrun = lrun * al + __expf(sk - mn); const float inv = al / lrun;
        bf16* yr = YB + ((size_t)b * L + t) * QW + h * 64;
#pragma unroll
        for (int j = 0; j < 8; ++j) { float v[8];
#pragma unroll
            for (int d = 0; d < 8; ++d) v[d] = o[8 * j + d] * inv;
            *(v4u*)(yr + 8 * j) = pack8(v); }
    }
}

__device__ __forceinline__ void p6_phase(const Ctx& C) {
    const int gw = C.bid * NWAVES + C.wave, NGW = C.nb * NWAVES, lane = C.lane;
    const float* mod = (const float*)(C.ws + WS_MOD); bf16* HX2 = (bf16*)(C.ws + WS_HX2); float* AFF = (float*)(C.ws + WS_AFF);
    const float* router = C.in[IN_ROUTER];
    for (int row = gw; row < M; row += NGW) {
        const float* xr = C.out + (size_t)row * D; const int mb = row >> 11;
        const float* sh = mod + (size_t)mb * MODW + 3 * D; const float* sc = sh + D;
        f32x4 v[4]; float s = 0.f;
#pragma unroll
        for (int j = 0; j < 4; ++j) { v[j] = *(const f32x4*)(xr + 4 * lane + 256 * j); s += (v[j][0] * v[j][0] + v[j][1] * v[j][1]) + (v[j][2] * v[j][2] + v[j][3] * v[j][3]); }
        const float rstd = 1.f / sqrtf(wave_sum(s) * (1.f / D) + EPS);
        float lg[16];
#pragma unroll
        for (int e = 0; e < 16; ++e) lg[e] = 0.f;
#pragma unroll
        for (int j = 0; j < 4; ++j) {
            const int c0 = 4 * lane + 256 * j; const f32x4 g = *(const f32x4*)(C.in[IN_NORM2] + c0), a = *(const f32x4*)(sc + c0), bb = *(const f32x4*)(sh + c0);
            float o[4];
#pragma unroll
            for (int i = 0; i < 4; ++i) { o[i] = v[j][i] * rstd * g[i] * (1.f + a[i]) + bb[i];
                const float* rr = router + (size_t)(c0 + i) * 16;
#pragma unroll
                for (int e = 0; e < 16; e += 4) { const f32x4 w = *(const f32x4*)(rr + e); lg[e] += o[i] * w[0]; lg[e + 1] += o[i] * w[1]; lg[e + 2] += o[i] * w[2]; lg[e + 3] += o[i] * w[3]; } }
            v2u w; w.x = pk2(o[0], o[1]); w.y = pk2(o[2], o[3]);
            *(v2u*)(HX2 + (size_t)row * D + c0) = w;
        }
        float mx = -1e30f;
#pragma unroll
        for (int e = 0; e < 16; ++e) { lg[e] = wave_sum(lg[e]); mx = fmaxf(mx, lg[e]); }
        float den = 0.f;
#pragma unroll
        for (int e = 0; e < 16; ++e) { lg[e] = expf(lg[e] - mx); den += lg[e]; }
        if (lane < 16) { float val = 0.f;
#pragma unroll
            for (int e = 0; e < 16; ++e) val = (lane == e) ? lg[e] : val;
            AFF[((size_t)mb * 16 + lane) * L + (row & 2047)] = val / den; }
    }
}

__device__ __forceinline__ void p7_phase(const Ctx& C) {
    const float* AFF = (const float*)(C.ws + WS_AFF); int* SLOT = (int*)(C.ws + WS_SLOT); float* SELG = (float*)(C.ws + WS_SELG);
    const bf16* HX2 = (const bf16*)(C.ws + WS_HX2); bf16* XIN = (bf16*)(C.ws + WS_XIN);
    LAS float* av = (LAS float*)C.lds;
    LAS int* sel = (LAS int*)(av + 2048);
    for (int item = C.bid; item < NB * NE; item += C.nb) {
        const int b = item >> 4, e = item & 15;
        __syncthreads();
        for (int i = C.tid; i < L; i += NT) av[i] = AFF[((size_t)b * 16 + e) * L + i];
        __syncthreads();
        for (int k = 0; k < 4; ++k) {
            const int t = C.tid + 512 * k; const float a = av[t]; int rank = 0;
            for (int s = 0; s < L; ++s) { const float o = av[s]; rank += (o > a || (o == a && s < t)) ? 1 : 0; }
            const bool in = rank < CAP;
            SLOT[((size_t)b * L + t) * 16 + e] = in ? rank : -1;
            if (in) { sel[rank] = t; SELG[e * 2048 + b * 256 + rank] = a; }
        }
        __syncthreads();
        for (int r = C.wave; r < CAP; r += NWAVES) {
            const int t = sel[r];
            const v4u* src = (const v4u*)(HX2 + ((size_t)b * L + t) * D); v4u* dst = (v4u*)(XIN + ((size_t)e * 2048 + b * 256 + r) * D);
            dst[C.lane] = src[C.lane]; dst[64 + C.lane] = src[64 + C.lane];
        }
    }
}

__device__ __forceinline__ void p10_phase(const Ctx& C) {
    const int gw = C.bid * NWAVES + C.wave, NGW = C.nb * NWAVES, lane = C.lane;
    const int* SLOT = (const int*)(C.ws + WS_SLOT); const bf16* Y = (const bf16*)(C.ws + WS_YBUF);
    for (int row = gw; row < M; row += NGW) {
        const int b = row >> 11;
        float acc[16];
#pragma unroll
        for (int i = 0; i < 16; ++i) acc[i] = 0.f;
        bool any = false;
        for (int e = 0; e < 16; ++e) {
            const int s = SLOT[(size_t)row * 16 + e];
            if (s >= 0) { any = true; const bf16* yr = Y + ((size_t)e * 2048 + b * 256 + s) * D;
                float f[8]; unpack8(*(const v4u*)(yr + 8 * lane), f);
#pragma unroll
                for (int i = 0; i < 8; ++i) acc[i] += f[i];
                unpack8(*(const v4u*)(yr + 512 + 8 * lane), f);
#pragma unroll
                for (int i = 0; i < 8; ++i) acc[8 + i] += f[i]; }
        }
        if (any) {
            float* o = C.out + (size_t)row * D;
#pragma unroll
            for (int hh = 0; hh < 2; ++hh) {
                f32x4 a = *(f32x4*)(o + hh * 512 + 8 * lane), bq = *(f32x4*)(o + hh * 512 + 8 * lane + 4);
#pragma unroll
                for (int i = 0; i < 4; ++i) { a[i] += acc[hh * 8 + i]; bq[i] += acc[hh * 8 + 4 + i]; }
                *(f32x4*)(o + hh * 512 + 8 * lane) = a; *(f32x4*)(o + hh * 512 + 8 * lane + 4) = bq;
            }
        }
    }
}

__global__ void __launch_bounds__(NT, 2) mk_fwd(Args args) {
    extern __shared__ __attribute__((aligned(16))) unsigned char lds_raw[];
    Ctx C;
    C.lds = (LAS unsigned char*)lds_raw; C.tid = threadIdx.x; C.lane = C.tid & 63; C.wave = __builtin_amdgcn_readfirstlane(C.tid >> 6);
    C.bid = blockIdx.x; C.nb = gridDim.x; C.out = args.out; C.ws = args.ws;
#pragma unroll
    for (int i = 0; i < 30; ++i) C.in[i] = args.in[i];
    volatile LAS unsigned* MISC = (volatile LAS unsigned*)(C.lds + MISC_OFF);
    if (C.tid < 32) MISC[C.tid] = 0u;
    __syncthreads();
    unsigned* ctl = (unsigned*)(C.ws + WS_CTL);
    XcdBarrier bar; bar.bar = ctl + CW_BAR + args.li * XCD_BAR_WORDS; bar.x = 0; bar.st = nullptr;
    if (N_LAUNCHES != NPH) bar = xcd_barrier_post(ctl + CW_BAR + args.li * XCD_BAR_WORDS, MISC + 8);
    const int lo = args.ph_lo, hi = args.ph_hi;
#ifndef PH_MASK
#define PH_MASK 0x7ff
#endif
#define IN(k) (((PH_MASK >> (k)) & 1) && lo <= (k) && (k) < hi)
#define SEAM(k) do { if (IN(k) && IN((k) + 1)) xcd_barrier(bar); } while (0)
    unsigned char* ws = C.ws;
    if (IN(0)) { p0_phase(C); } SEAM(0);
    if (IN(1)) { p1_phase(C); } SEAM(1);
    if (IN(2)) {
        {
            UnitsStd U{(const bf16*)(ws + WS_WINT), (const bf16*)(ws + WS_HX), D, D, 6, 64, 0};
            EpiZ E{(bf16*)(ws + WS_ZT)};
            gemm_naive(C, D, D, D, U, E);
        }
        {
            UnitsIn U{(const bf16*)(ws + WS_HX), (const bf16*)(ws + WS_WINT) + (size_t)OFF_Q * D};
            EpiIn E{(bf16*)(ws + WS_QRAW), (bf16*)(ws + WS_KRAW), (bf16*)(ws + WS_VB), (bf16*)(ws + WS_KC), (bf16*)(ws + WS_VC), (bf16*)(ws + WS_GA), (bf16*)(ws + WS_GB)};
            gemm_naive(C, D, D, D, U, E);
        }
    } SEAM(2);
    if (IN(3)) {
        for (int c = C.bid; c < HW; c += C.nb) hyena_naive(C, c);
        __syncthreads();
        for (int it = C.bid; it < NB * 2 * 16; it += C.nb) attn_naive(C, it);
    } SEAM(3);
    if (IN(4)) {
        {
            UnitsStd U{(const bf16*)(ws + WS_YA), (const bf16*)(ws + WS_WAT), HW, HW, 64, 4, 0};
            EpiT1 E{(const bf16*)(ws + WS_GA), (bf16*)(ws + WS_TA)};
            gemm_naive(C, HW, HW, HW, U, E);
        }
        asm volatile("s_waitcnt vmcnt(0)" ::: "memory"); __syncthreads();
        {
            UnitsStd U{(const bf16*)(ws + WS_YB), (const bf16*)(ws + WS_WBT), HW, HW, 64, 4, 0};
            EpiT2 E{(const bf16*)(ws + WS_GB), (const bf16*)(ws + WS_TA), (bf16*)(ws + WS_MM)};
            gemm_naive(C, HW, HW, HW, U, E);
        }
    } SEAM(4);
    if (IN(5)) {
        UnitsStd U{(const bf16*)(ws + WS_MM), (const bf16*)(ws + WS_WOUTT), D, D, 64, 4, 0};
        EpiOut E{C.in[IN_X], (const float*)(ws + WS_MOD), C.out};
        gemm_naive(C, D, D, D, U, E);
    } SEAM(5);
    if (IN(6)) { p6_phase(C); } SEAM(6);
    if (IN(7)) { p7_phase(C); } SEAM(7);
    if (IN(8)) {
        UnitsStd U{(const bf16*)(ws + WS_XIN), (const bf16*)(ws + WS_W1T), D, D, 128, 16, (size_t)4096 * D};
        EpiH E{(bf16*)(ws + WS_HB)};
        gemm_naive(C, D, D, D, U, E);
    } SEAM(8);
    if (IN(9)) {
        UnitsStd U{(const bf16*)(ws + WS_HB), (const bf16*)(ws + WS_W2T), DFF, DFF, 128, 4, (size_t)1024 * DFF};
        EpiY E{(const float*)(ws + WS_SELG), (const float*)(ws + WS_MOD), (bf16*)(ws + WS_YBUF)};
        gemm_naive(C, DFF, DFF, DFF, U, E);
    } SEAM(9);
    if (IN(10)) { p10_phase(C); }
#undef IN
#undef SEAM
}

extern "C" void kernel_launch(void* const* d_in, const int* in_sizes, int n_in, void* d_out, int out_size, void* d_ws, size_t ws_size, hipStream_t stream) {
    static int grid = 0;
    if (grid == 0) {
        if (n_in != 30 || in_sizes[0] != M * D || out_size != M * D || ws_size < WS_END) { fprintf(stderr, "kernel_launch: unexpected shapes: n_in %d in0 %d out %d ws %zu (need %zu)\n", n_in, n_in > 0 ? in_sizes[0] : -1, out_size, ws_size, (size_t)WS_END); grid = -1; return; }
        int dev = 0, cus = 0, per_cu = 0;
        if (hipGetDevice(&dev) != hipSuccess || hipDeviceGetAttribute(&cus, hipDeviceAttributeMultiprocessorCount, dev) != hipSuccess) { grid = -1; return; }
        if (hipFuncSetAttribute((const void*)mk_fwd, hipFuncAttributeMaxDynamicSharedMemorySize, LDS_BYTES) != hipSuccess) { fprintf(stderr, "kernel_launch: hipFuncSetAttribute failed\n"); grid = -1; return; }
        if (hipOccupancyMaxActiveBlocksPerMultiprocessor(&per_cu, (const void*)mk_fwd, NT, LDS_BYTES) != hipSuccess || per_cu < 1) { fprintf(stderr, "kernel_launch: occupancy query says %d\n", per_cu); per_cu = 1; }
        (void)hipGetLastError();
        grid = cus;
    }
    if (grid < 0) return;
    if (hipMemsetAsync((char*)d_ws + WS_CTL, 0, CTL_ZERO_BYTES, stream) != hipSuccess) { fprintf(stderr, "kernel_launch: memset failed\n"); return; }
    Args a{};
    for (int i = 0; i < 30; ++i) a.in[i] = (const float*)d_in[i];
    a.out = (float*)d_out; a.ws = (unsigned char*)d_ws;
    if (N_LAUNCHES == NPH) {
        for (int li = 0; li < NPH; ++li) { a.ph_lo = li; a.ph_hi = li + 1; a.li = 0; hipLaunchKernelGGL(mk_fwd, dim3(grid), dim3(NT), LDS_BYTES, stream, a); }
    } else {
        a.ph_lo = 0; a.ph_hi = NPH; a.li = 0;
        hipLaunchKernelGGL(mk_fwd, dim3(grid), dim3(NT), LDS_BYTES, stream, a);
    }
}
```

```cpp
#include <hip/hip_runtime.h>
#include <cstdio>
#include <cstdint>

#define GAS __attribute__((address_space(1)))
#define LAS __attribute__((address_space(3)))
typedef unsigned short bf16;
typedef unsigned v4u __attribute__((ext_vector_type(4)));
typedef unsigned v2u __attribute__((ext_vector_type(2)));
typedef float f32x4 __attribute__((ext_vector_type(4)));
typedef short bf16x8 __attribute__((ext_vector_type(8)));

#ifndef DUP_MASK
#define DUP_MASK 0
#endif
#ifndef DUP_SUB
#define DUP_SUB 0
#endif
#ifndef MK_N_LAUNCHES
#define MK_N_LAUNCHES 1
#endif
constexpr int NPH = 12;
constexpr int N_LAUNCHES = MK_N_LAUNCHES;
constexpr int NWAVES = 8, NT = NWAVES * 64;

constexpr int D = 1024, NB = 8, L = 2048, LC = 256, M = NB * L, MC = NB * LC, MT = M + MC;
constexpr int HW = 512, QW = 512, KVW = 128, NE = 16, CAP = 256, DFF = 2048, INW = 4352;
constexpr int OFF_Q = 1536, OFF_K = 2048, OFF_V = 2176, OFF_G = 2304;
constexpr int MODW = 6 * D;
constexpr float EPS = 1e-6f;
constexpr int GT_LEN = 4096;

constexpr size_t MiB = 1u << 20;
constexpr size_t WS_CTL = 0, CTL_ZERO_BYTES = 1 * MiB;
constexpr size_t WS_MOD = 1 * MiB;
constexpr size_t WS_H3 = 1 * MiB + 512 * 1024;
constexpr size_t WS_ROPE = 2 * MiB;
constexpr size_t WS_AFF = 3 * MiB;
constexpr size_t WS_SLOT = 4 * MiB;
constexpr size_t WS_SELG = 5 * MiB;
constexpr size_t WS_GTAB = 6 * MiB;
constexpr size_t WS_WINT = 14 * MiB;
constexpr size_t WS_WAT = 23 * MiB;
constexpr size_t WS_WBT = 24 * MiB;
constexpr size_t WS_WOUTT = 25 * MiB;
constexpr size_t WS_W1T = 28 * MiB;
constexpr size_t WS_HX8 = 92 * MiB;
constexpr size_t WS_WG8 = 108 * MiB;
constexpr size_t WS_W2T = 156 * MiB;
constexpr size_t WS_R1 = 220 * MiB;
constexpr size_t WS_HX = WS_R1;
constexpr size_t WS_ZT = WS_R1 + 36 * MiB;
constexpr size_t WS_QRAW = WS_R1 + 84 * MiB;
constexpr size_t WS_KRAW = WS_R1 + 100 * MiB;
constexpr size_t WS_VB = WS_R1 + 104 * MiB;
constexpr size_t WS_KC = WS_R1 + 108 * MiB;
constexpr size_t WS_VC = WS_R1 + 108 * MiB + 512 * 1024;
constexpr size_t WS_YAT = WS_R1 + 110 * MiB;
constexpr size_t WS_TA = WS_R1;
constexpr size_t WS_MM = WS_R1 + 32 * MiB;
constexpr size_t WS_HB = WS_R1;
constexpr size_t WS_R2 = 348 * MiB;
constexpr size_t WS_GA = WS_R2, WS_GB = WS_R2 + 32 * MiB;
constexpr size_t WS_XIN = WS_R2;
constexpr size_t WS_YBUF = WS_R2;
constexpr size_t WS_R3 = 412 * MiB;
constexpr size_t WS_YA = WS_R3, WS_YB = WS_R3 + 16 * MiB;
constexpr size_t WS_HX2 = WS_R3;
constexpr size_t WS_XNEW = 444 * MiB;
constexpr size_t WS_END = 508 * MiB;

constexpr int CW_BAR = 4096;
constexpr int LDS_BYTES = 147456;
constexpr int MISC_OFF = 147456 - 256;

__device__ __forceinline__ unsigned f2bf(float f) { unsigned u = __builtin_bit_cast(unsigned, f); return (u + 0x7fffu + ((u >> 16) & 1u)) >> 16; }
typedef float f32x2_t __attribute__((ext_vector_type(2)));
typedef __bf16 bf16x2_t __attribute__((ext_vector_type(2)));
__device__ __forceinline__ unsigned cvtpk(float lo, float hi) { f32x2_t v = {lo, hi}; bf16x2_t b = __builtin_convertvector(v, bf16x2_t); return __builtin_bit_cast(unsigned, b); }
__device__ __forceinline__ unsigned pk2(float lo, float hi) { return cvtpk(lo, hi); }
__device__ __forceinline__ unsigned pk4_fp8(float a, float b, float c, float d) { int w = 0; w = __builtin_amdgcn_cvt_pk_fp8_f32(a, b, w, false); w = __builtin_amdgcn_cvt_pk_fp8_f32(c, d, w, true); return (unsigned)w; }
__device__ __forceinline__ float bf2f(unsigned b) { return __builtin_bit_cast(float, b << 16); }
__device__ __forceinline__ float bflo(unsigned w) { return __builtin_bit_cast(float, w << 16); }
__device__ __forceinline__ float bfhi(unsigned w) { return __builtin_bit_cast(float, w & 0xffff0000u); }
__device__ __forceinline__ float rbf(float f) { return bf2f(f2bf(f)); }
__device__ __forceinline__ void unpack8_u8(v2u w, float* o) {
    const float k = 1.f / 255.f;
    o[0] = (float)(w.x & 255u) * k; o[1] = (float)((w.x >> 8) & 255u) * k; o[2] = (float)((w.x >> 16) & 255u) * k; o[3] = (float)(w.x >> 24) * k;
    o[4] = (float)(w.y & 255u) * k; o[5] = (float)((w.y >> 8) & 255u) * k; o[6] = (float)((w.y >> 16) & 255u) * k; o[7] = (float)(w.y >> 24) * k; }
__device__ __forceinline__ void unpack8(v4u w, float* o) { o[0] = bflo(w.x); o[1] = bfhi(w.x); o[2] = bflo(w.y); o[3] = bfhi(w.y); o[4] = bflo(w.z); o[5] = bfhi(w.z); o[6] = bflo(w.w); o[7] = bfhi(w.w); }
__device__ __forceinline__ v4u pack8(const float* v) { v4u w; w.x = pk2(v[0], v[1]); w.y = pk2(v[2], v[3]); w.z = pk2(v[4], v[5]); w.w = pk2(v[6], v[7]); return w; }
__device__ __forceinline__ float siluf(float x) { return x * __builtin_amdgcn_rcpf(1.f + __expf(-x)); }
__device__ __forceinline__ float sigmf(float x) { return __builtin_amdgcn_rcpf(1.f + __expf(-x)); }
__device__ __forceinline__ float wave_sum(float v) {
#pragma unroll
    for (int o = 1; o < 64; o <<= 1) v += __shfl_xor(v, o);
    return v;
}
#define LDS_WAIT() asm volatile("s_waitcnt lgkmcnt(0)" ::: "memory")
#define LDS_BARRIER() do { asm volatile("s_waitcnt lgkmcnt(0)" ::: "memory"); __builtin_amdgcn_s_barrier(); asm volatile("" ::: "memory"); } while (0)

#define XB_TMO      128
#define XB_XCNT(j)  (256  + 64 * (j))
#define XB_XSUB(j)  (1280 + 64 * (j))
#define XB_XGEN(j)  (2304 + 64 * (j))
#define XB_TOP      3328
#define XB_TOPGEN   3392
#define XCD_BAR_WORDS 3456
#define XB_SPIN_CAP (1u << 25)
__device__ __forceinline__ unsigned xb_ld(unsigned* p)              { return __hip_atomic_load(p, __ATOMIC_RELAXED, __HIP_MEMORY_SCOPE_AGENT); }
__device__ __forceinline__ unsigned xb_add(unsigned* p, unsigned v) { return __hip_atomic_fetch_add(p, v, __ATOMIC_RELAXED, __HIP_MEMORY_SCOPE_AGENT); }
__device__ __forceinline__ unsigned xb_xcc_id() { return (unsigned)__builtin_amdgcn_s_getreg((3 << 11) | 20) & 0xFu; }
#define XB_SPIN(cond, bar) do { unsigned _sp = 0; while (cond) { __builtin_amdgcn_s_sleep(1); \
    if ((++_sp & 255u) == 0u) { if (xb_ld(&(bar)[XB_TMO])) break; if (_sp > XB_SPIN_CAP) { atomicAdd(&(bar)[XB_TMO], 1u); break; } } } } while (0)
struct XcdBarrier { unsigned* bar; unsigned x; volatile LAS unsigned* st; };
__device__ __forceinline__ XcdBarrier xcd_barrier_post(unsigned* bar, volatile LAS unsigned* st) {
    XcdBarrier b; b.bar = bar; b.x = xb_xcc_id(); b.st = st;
    if (threadIdx.x == 0) (void)xb_add(&bar[XB_XCNT(b.x)], 1u);
    return b;
}
__device__ __forceinline__ void xcd_barrier_complete(unsigned* bar, unsigned x, unsigned& nloc, unsigned& nx) {
    const unsigned G = gridDim.x * gridDim.y * gridDim.z;
    unsigned sum, cnt, mine, sp = 0u;
    for (;;) {
        sum = 0u; cnt = 0u; mine = 0u;
#pragma unroll
        for (unsigned j = 0; j < 16; ++j) { const unsigned c = xb_ld(&bar[XB_XCNT(j)]); sum += c; cnt += (c > 0u) ? 1u : 0u; mine = (j == x) ? c : mine; }
        if (sum == G) break;
        __builtin_amdgcn_s_sleep(1);
        if ((++sp & 255u) == 0u) { if (xb_ld(&bar[XB_TMO])) break; if (sp > XB_SPIN_CAP) { atomicAdd(&bar[XB_TMO], 1u); break; } }
    }
    nloc = mine > 0u ? mine : 1u; nx = cnt > 0u ? cnt : 1u;
}
__device__ __forceinline__ void xcd_barrier(const XcdBarrier& b) {
    asm volatile("s_waitcnt vmcnt(0)" ::: "memory");
    __syncthreads();
    if (threadIdx.x == 0) {
        unsigned* bar = b.bar;
        __builtin_amdgcn_s_waitcnt(0);
        unsigned nloc = b.st[0], nx = b.st[1];
        if (nloc == 0u) { xcd_barrier_complete(bar, b.x, nloc, nx); b.st[0] = nloc; b.st[1] = nx; }
        const unsigned old = xb_add(&bar[XB_XSUB(b.x)], 1u);
        const unsigned gen = old / nloc;
        if (old + 1u == (gen + 1u) * nloc) {
            __builtin_amdgcn_fence(__ATOMIC_RELEASE, "agent");
            asm volatile("s_waitcnt vmcnt(0)" ::: "memory");
            const unsigned og = xb_add(&bar[XB_TOP], 1u);
            const unsigned tg = og / nx;
            if (og + 1u == (tg + 1u) * nx) xb_add(&bar[XB_TOPGEN], 1u);
            else XB_SPIN(xb_ld(&bar[XB_TOPGEN]) == tg, bar);
            __builtin_amdgcn_fence(__ATOMIC_ACQUIRE, "agent");
            xb_add(&bar[XB_XGEN(b.x)], 1u);
            asm volatile("s_waitcnt vmcnt(0)" ::: "memory");
        } else {
            XB_SPIN(xb_ld(&bar[XB_XGEN(b.x)]) == gen, bar);
            __builtin_amdgcn_fence(__ATOMIC_ACQUIRE, "agent");
            asm volatile("s_waitcnt vmcnt(0)" ::: "memory");
        }
    }
    __syncthreads();
}

constexpr int CW_SB0 = 2048;
__device__ __forceinline__ void sb_arrive(unsigned* cnt) {
    asm volatile("s_waitcnt vmcnt(0)" ::: "memory");
    __syncthreads();
    if (threadIdx.x == 0) { __builtin_amdgcn_fence(__ATOMIC_RELEASE, "agent"); asm volatile("s_waitcnt vmcnt(0)" ::: "memory"); (void)xb_add(cnt, 1u); }
}
__device__ __forceinline__ void sb_wait(unsigned* cnt, unsigned target, unsigned* tmo) {
    if (threadIdx.x == 0) {
        unsigned sp = 0u;
        while (xb_ld(cnt) < target) { __builtin_amdgcn_s_sleep(1); if ((++sp & 255u) == 0u) { if (xb_ld(tmo)) break; if (sp > XB_SPIN_CAP) { atomicAdd(tmo, 1u); break; } } }
        __builtin_amdgcn_fence(__ATOMIC_ACQUIRE, "agent"); asm volatile("s_waitcnt vmcnt(0)" ::: "memory");
    }
    __syncthreads();
}

struct Args { const float* in[30]; float* out; unsigned char* ws; int ph_lo, ph_hi, li, sub; };
struct Ctx {
    LAS unsigned char* lds; int tid, lane, wave, bid, nb, sub;
    const float* in[30]; float* out; unsigned char* ws;
};
#define IN_X 0
#define IN_C 1
#define IN_CTX 2
#define IN_CCTX 3
#define IN_ADAW 4
#define IN_ADAB 5
#define IN_NORM1 6
#define IN_NORM2 7
#define IN_WIN 8
#define IN_CONVW 9
#define IN_CONVB 10
#define IN_FW1 11
#define IN_FB1 12
#define IN_FW2 13
#define IN_FB2 14
#define IN_FW3 15
#define IN_FB3 16
#define IN_FFREQ 17
#define IN_FOUT 18
#define IN_HBIAS 19
#define IN_QNORM 20
#define IN_KNORM 21
#define IN_SINK 22
#define IN_WA 23
#define IN_WB 24
#define IN_WOUT 25
#define IN_ROUTER 26
#define IN_WGATE 27
#define IN_WUP 28
#define IN_WDOWN 29

template <class Epi, class Units>
__device__ __forceinline__ void gemm_naive(const Ctx& C, int K, int lda, int ldb, const Units& U, const Epi& E) {
    LAS float* As = (LAS float*)C.lds;
    LAS float* Bs = As + 32 * 132;
    const int tid = C.tid, ty = tid >> 4, tx = tid & 15;
    for (int idx = C.bid;; idx += C.nb) {
        int pm, pn; const bf16* Ab; const bf16* Bb;
        if (!U.get(idx, pm, pn, Ab, Bb)) break;
        for (int half = 0; half < 2; ++half) {
            float acc[4][16];
#pragma unroll
            for (int r = 0; r < 4; ++r)
#pragma unroll
                for (int j = 0; j < 16; ++j) acc[r][j] = 0.f;
            for (int k0 = 0; k0 < K; k0 += 32) {
                {
                    const int row = tid >> 2, kc = tid & 3;
                    const v4u w = *(const v4u*)(Ab + (size_t)(half * 128 + row) * lda + k0 + kc * 8);
                    float f[8]; unpack8(w, f);
#pragma unroll
                    for (int j = 0; j < 8; ++j) As[(kc * 8 + j) * 132 + row] = f[j];
                }
#pragma unroll
                for (int i = 0; i < 2; ++i) {
                    const int c = tid + 512 * i, row = c >> 2, kc = c & 3;
                    const v4u w = *(const v4u*)(Bb + (size_t)row * ldb + k0 + kc * 8);
                    float f[8]; unpack8(w, f);
#pragma unroll
                    for (int j = 0; j < 8; ++j) Bs[(kc * 8 + j) * 260 + row] = f[j];
                }
                __syncthreads();
#pragma unroll 4
                for (int k = 0; k < 32; ++k) {
                    const f32x4 a = *(const LAS f32x4*)(As + k * 132 + ty * 4);
                    const f32x4 b0 = *(const LAS f32x4*)(Bs + k * 260 + tx * 8), b1 = *(const LAS f32x4*)(Bs + k * 260 + tx * 8 + 4);
                    const f32x4 b2 = *(const LAS f32x4*)(Bs + k * 260 + 128 + tx * 8), b3 = *(const LAS f32x4*)(Bs + k * 260 + 128 + tx * 8 + 4);
#pragma unroll
                    for (int r = 0; r < 4; ++r) {
#pragma unroll
                        for (int j = 0; j < 4; ++j) { acc[r][j] += a[r] * b0[j]; acc[r][4 + j] += a[r] * b1[j]; acc[r][8 + j] += a[r] * b2[j]; acc[r][12 + j] += a[r] * b3[j]; }
                    }
                }
                __syncthreads();
            }
#pragma unroll
            for (int r = 0; r < 4; ++r) E(pm * 256 + half * 128 + ty * 4 + r, pn, tx * 8, &acc[r][0], &acc[r][8]);
        }
    }
}


namespace pg8 {
constexpr int BM = 256, BK = 64, HALF = 128, HTB = HALF * BK * 2, NXCD = 8, WGM = 8;
__device__ __forceinline__ int lds_byte(int r, int c) { const int st = (r >> 4) * 2 + (c >> 5), rr = r & 15, cc = c & 31, ob = rr * 64 + cc * 2; return st * 1024 + (ob ^ (((ob >> 9) & 1) << 5)); }
__device__ __forceinline__ void stage_rc(int b, int& R, int& C) { const int st = b / 1024, sb = b % 1024, swz = sb ^ (((sb >> 9) & 1) << 5); R = (st >> 1) * 16 + swz / 64; C = (st & 1) * 32 + (swz % 64) / 2; }
__device__ __forceinline__ int perm32(int rho) { const int n = rho >> 4, i = rho & 15; return 8 * (i >> 2) + 4 * n + (i & 3); }
struct Unit { int pm, pn, kind; const char* A; const char* B; };
__device__ __forceinline__ void tile_of(int w, int nM, int nN, int& pm, int& pn) {
    const int nwg = nM * nN; int wgid = w; { const int q = nwg / NXCD, r = nwg % NXCD, xcd = wgid % NXCD, off = wgid / NXCD; wgid = (xcd < r ? xcd * (q + 1) : r * (q + 1) + (xcd - r) * q) + off; }
    const int nig = WGM * nN, gid = wgid / nig, fm = gid * WGM, gsz = (nM - fm) < WGM ? (nM - fm) : WGM;
    pm = fm + ((wgid % nig) % gsz); pn = (wgid % nig) / gsz;
}
template <class F> struct Epi {
    F f;
    __device__ __forceinline__ void operator()(const f32x4 (&acc)[2][2][4][2], const Unit& u, int wr, int wc, int fr, int fq) const {
#pragma unroll
        for (int ai = 0; ai < 2; ++ai)
#pragma unroll
            for (int m = 0; m < 4; ++m) {
                float v0[8], v1[8];
#pragma unroll
                for (int n = 0; n < 2; ++n)
#pragma unroll
                    for (int i = 0; i < 4; ++i) { v0[4 * n + i] = acc[ai][0][m][n][i]; v1[4 * n + i] = acc[ai][1][m][n][i]; }
                f(u.kind, u.pm * BM + ai * HALF + wr * 64 + m * 16 + fr, u.pn, wc * 32 + 8 * fq, v0, v1);
            }
    }
};
template <class EpiT, class Sched, bool FP8 = false>
__device__ __forceinline__ void gemm_phase(LAS unsigned char* lds, const int K, const Sched& S, const EpiT& E) {
    const int tid = threadIdx.x, wid = __builtin_amdgcn_readfirstlane(tid >> 6), lane = tid & 63, wr = wid >> 2, wc = wid & 3, fr = lane & 15, fq = lane >> 4;
    const int nt = K / BK;
    unsigned voffA[2], voffB[2];
#pragma unroll
    for (int i = 0; i < 2; ++i) { int R, C; stage_rc(tid * 16 + i * 8192, R, C); const int Rb = (R & ~31) + perm32(R & 31);
        voffA[i] = (unsigned)(R * K + C) * 2u; voffB[i] = (unsigned)(Rb * K + C) * 2u; }
    const size_t kstep = (size_t)(BK * 2);
    const size_t hstep = (size_t)HALF * K * 2;
    const unsigned ldsw = (unsigned)wid * 1024u;
    const int aoff = lds_byte(wr * 64 + fr, fq * 8), boff = lds_byte(wc * 32 + fr, fq * 8);
#define PG8_SA(b, h) (((b) * 2 + (h)) * HTB)
#define PG8_SB(b, h) ((4 + (b) * 2 + (h)) * HTB)
#define PG8_STAGE(bufoff, gbase, voff) do { _Pragma("unroll") for (int _i = 0; _i < 2; ++_i) \
        __builtin_amdgcn_global_load_lds((const unsigned*)((const char*)(gbase) + (voff)[_i]), (LAS unsigned*)(lds + (bufoff) + ldsw + _i * 8192), 16, 0, 0); } while (0)
#define PG8_LDA(dst, b, h) do { _Pragma("unroll") for (int m = 0; m < 4; ++m) { if constexpr (FP8) { \
        dst##8[m] = __builtin_shufflevector(*(const LAS v4i_*)(lds + PG8_SA(b, h) + aoff + m * 2048), *(const LAS v4i_*)(lds + PG8_SA(b, h) + aoff + m * 2048 + 1024), 0, 1, 2, 3, 4, 5, 6, 7); } \
        else { _Pragma("unroll") for (int k = 0; k < 2; ++k) dst[m][k] = *(const LAS bf16x8*)(lds + PG8_SA(b, h) + aoff + m * 2048 + k * 1024); } } } while (0)
#define PG8_LDB(dst, b, h) do { _Pragma("unroll") for (int n = 0; n < 2; ++n) { if constexpr (FP8) { \
        dst##8[n] = __builtin_shufflevector(*(const LAS v4i_*)(lds + PG8_SB(b, h) + boff + n * 2048), *(const LAS v4i_*)(lds + PG8_SB(b, h) + boff + n * 2048 + 1024), 0, 1, 2, 3, 4, 5, 6, 7); } \
        else { _Pragma("unroll") for (int k = 0; k < 2; ++k) dst[n][k] = *(const LAS bf16x8*)(lds + PG8_SB(b, h) + boff + n * 2048 + k * 1024); } } } while (0)
#define PG8_MMA(ai, bj, At, Bt) do { __builtin_amdgcn_s_setprio(1); _Pragma("unroll") for (int m = 0; m < 4; ++m) _Pragma("unroll") for (int n = 0; n < 2; ++n) { \
        if constexpr (FP8) asm volatile("v_mfma_scale_f32_16x16x128_f8f6f4 %0, %1, %2, %0, %3, %4 op_sel_hi:[0,0,0]" : "+v"(acc[ai][bj][m][n]) : "v"(Bt##8[n]), "v"(At##8[m]), "v"(sc_w), "v"(sc_x)); \
        else { _Pragma("unroll") for (int k = 0; k < 2; ++k) acc[ai][bj][m][n] = __builtin_amdgcn_mfma_f32_16x16x32_bf16(Bt[n][k], At[m][k], acc[ai][bj][m][n], 0, 0, 0); } } \
        __builtin_amdgcn_s_setprio(0); } while (0)
#define PG8_WAIT_V(n) asm volatile("s_waitcnt vmcnt(" #n ")" ::: "memory")
#define PG8_WAIT_L(n) asm volatile("s_waitcnt lgkmcnt(" #n ")" ::: "memory")
#define PG8_BAR __builtin_amdgcn_s_barrier()
#define PG8_SCHED __builtin_amdgcn_sched_barrier(0)
    Unit cur, nxt; int ui = 0;
    if (!S.next(0, cur)) return;
    f32x4 acc[2][2][4][2];
#pragma unroll
    for (int a = 0; a < 2; ++a)
#pragma unroll
        for (int b = 0; b < 2; ++b)
#pragma unroll
            for (int m = 0; m < 4; ++m)
#pragma unroll
                for (int n = 0; n < 2; ++n) acc[a][b][m][n] = (f32x4){0.f, 0.f, 0.f, 0.f};
    typedef int v4i_ __attribute__((ext_vector_type(4))); typedef int v8i_ __attribute__((ext_vector_type(8)));
    const int sc_w = 0x7a7a7a7a, sc_x = 0x7f7f7f7f;
    bf16x8 At[4][2], B0[2][2], B1[2][2]; v8i_ At8[4], B08[2], B18[2];
    const char* cA = cur.A; const char* cB = cur.B;
    PG8_STAGE(PG8_SB(0, 0), cB, voffB); PG8_STAGE(PG8_SB(0, 1), cB + hstep, voffB); PG8_STAGE(PG8_SA(0, 0), cA, voffA); PG8_STAGE(PG8_SA(0, 1), cA + hstep, voffA);
    if (wr == 1) PG8_BAR;
    PG8_WAIT_V(2); PG8_BAR;
    PG8_STAGE(PG8_SB(1, 0), cB + kstep, voffB); PG8_STAGE(PG8_SA(1, 0), cA + kstep, voffA); PG8_STAGE(PG8_SB(1, 1), cB + hstep + kstep, voffB);
    PG8_WAIT_V(6); PG8_BAR;
    for (;;) {
        const bool has_next = S.next(ui + 1, nxt);
        const char* nA = has_next ? nxt.A : cA; const char* nB = has_next ? nxt.B : cB;
        for (int t = 0; t < nt; t += 2) {
            const bool last = (t == nt - 2);
            const char* a1 = cA + (size_t)(t + 1) * kstep;
            const char* a2 = last ? nA : cA + (size_t)(t + 2) * kstep; const char* b2 = last ? nB : cB + (size_t)(t + 2) * kstep;
            const char* a3 = a2 + kstep; const char* b3 = b2 + kstep;
            PG8_LDB(B0, 0, 0); PG8_LDB(B1, 0, 1); PG8_SCHED; PG8_LDA(At, 0, 0); PG8_STAGE(PG8_SA(1, 1), a1 + hstep, voffA);
            PG8_WAIT_V(8); PG8_WAIT_L(0); PG8_BAR; PG8_MMA(0, 0, At, B0); PG8_MMA(0, 1, At, B1); PG8_BAR; PG8_SCHED;
            PG8_LDA(At, 0, 1); PG8_STAGE(PG8_SB(0, 0), b2, voffB); PG8_STAGE(PG8_SB(0, 1), b2 + hstep, voffB); PG8_STAGE(PG8_SA(0, 0), a2, voffA);
            PG8_WAIT_V(8); PG8_WAIT_L(0); PG8_BAR; PG8_MMA(1, 0, At, B0); PG8_MMA(1, 1, At, B1); PG8_BAR; PG8_SCHED;
            PG8_LDB(B0, 1, 0); PG8_LDB(B1, 1, 1); PG8_SCHED; PG8_LDA(At, 1, 0); PG8_STAGE(PG8_SA(0, 1), a2 + hstep, voffA);
            PG8_WAIT_V(8); PG8_WAIT_L(0); PG8_BAR; PG8_MMA(0, 0, At, B0); PG8_MMA(0, 1, At, B1); PG8_BAR; PG8_SCHED;
            PG8_LDA(At, 1, 1); PG8_STAGE(PG8_SB(1, 0), b3, voffB); PG8_STAGE(PG8_SB(1, 1), b3 + hstep, voffB); PG8_STAGE(PG8_SA(1, 0), a3, voffA);
            PG8_WAIT_V(8); PG8_WAIT_L(0); PG8_BAR; PG8_MMA(1, 0, At, B0); PG8_MMA(1, 1, At, B1); PG8_BAR; PG8_SCHED;
        }
        if (wr == 0) PG8_BAR;
        if constexpr (FP8) asm volatile("s_nop 15\n\ts_nop 15" ::: "memory");
        E(acc, cur, wr, wc, fr, fq);
        if (!has_next) break;
#pragma unroll
        for (int a = 0; a < 2; ++a)
#pragma unroll
            for (int b = 0; b < 2; ++b)
#pragma unroll
                for (int m = 0; m < 4; ++m)
#pragma unroll
                    for (int n = 0; n < 2; ++n) acc[a][b][m][n] = (f32x4){0.f, 0.f, 0.f, 0.f};
        cur = nxt; cA = nA; cB = nB; ++ui;
        if (wr == 1) PG8_BAR;
    }
    PG8_WAIT_V(0);
    PG8_BAR;
#undef PG8_SA
#undef PG8_SB
#undef PG8_STAGE
#undef PG8_LDA
#undef PG8_LDB
#undef PG8_MMA
#undef PG8_WAIT_V
#undef PG8_WAIT_L
#undef PG8_BAR
#undef PG8_SCHED
}
struct SchedStd {
    const char* A; const char* Bt; int K, nM, nN, G, c; size_t bgroup;
    __device__ __forceinline__ bool next(int i, Unit& u) const {
        const long Lid = (long)i * G + c; if (Lid >= (long)nM * nN) return false;
        tile_of((int)Lid, nM, nN, u.pm, u.pn); u.kind = 0;
        u.A = A + (size_t)u.pm * 256 * K * 2; u.B = Bt + (size_t)(u.pm >> 3) * bgroup + (size_t)u.pn * 256 * K * 2; return true;
    }
};
struct SchedIn {
    const char* HX; const char* WINT; int G, c;
    __device__ __forceinline__ bool next(int i, Unit& u) const {
        const long Lid = (long)i * G + c;
        if (Lid < 384) { tile_of((int)Lid, 6, 64, u.pm, u.pn); u.kind = 0; u.A = WINT + (size_t)u.pm * 256 * D * 2; u.B = HX + (size_t)u.pn * 256 * D * 2; return true; }
        if (Lid < 384 + 192) { tile_of((int)Lid - 384, 64, 3, u.pm, u.pn); u.kind = 1; u.A = HX + (size_t)u.pm * 256 * D * 2; u.B = WINT + (size_t)(OFF_Q + u.pn * 256) * D * 2; return true; }
        if (Lid < 384 + 192 + 8) { u.pm = 64 + (int)(Lid - 576); u.pn = 2; u.kind = 1; u.A = HX + (size_t)u.pm * 256 * D * 2; u.B = WINT + (size_t)(OFF_Q + 512) * D * 2; return true; }
        return false;
    }
};
struct SchedGate {
    const char* HX8; const char* WG8; int G, c;
    __device__ __forceinline__ bool next(int i, Unit& u) const {
        long Lid;
        if (G == 256) { if (i == 0) Lid = c; else if (i == 1 && c >= 72) Lid = 256 + (c - 72); else if (i == 2 && c >= 72 && c < 144) Lid = 440 + (c - 72); else return false; }
        else { Lid = (long)i * G + c; if (Lid >= 512) return false; }
        tile_of((int)Lid, 64, 8, u.pm, u.pn); u.kind = 1;
        u.A = HX8 + (size_t)u.pm * 256 * D; u.B = WG8 + (size_t)u.pn * 256 * D; u.pn += 3; return true;
    }
};
struct SchedP5 {
    const char* YA; const char* WAT; const char* YB; const char* WBT; int G, c;
    __device__ __forceinline__ bool next(int i, Unit& u) const {
        const long tile = (long)(i >> 1) * G + c; if (tile >= 256) return false;
        tile_of((int)tile, 64, 4, u.pm, u.pn); u.kind = i & 1;
        u.A = ((i & 1) ? YB : YA) + (size_t)u.pm * 256 * HW * 2; u.B = ((i & 1) ? WBT : WAT) + (size_t)u.pn * 256 * HW * 2; return true;
    }
};
}

struct UnitsStd {
    const bf16* A; const bf16* Bt; int lda, ldb, nM, nN; size_t bgroup;
    __device__ __forceinline__ bool get(int idx, int& pm, int& pn, const bf16*& Ab, const bf16*& Bb) const {
        if (idx >= nM * nN) return false;
        pm = idx / nN; pn = idx % nN;
        Ab = A + (size_t)pm * 256 * lda; Bb = Bt + (size_t)(pm >> 3) * bgroup + (size_t)pn * 256 * ldb; return true;
    }
};
struct UnitsIn {
    const bf16* A; const bf16* Bt;
    __device__ __forceinline__ bool get(int idx, int& pm, int& pn, const bf16*& Ab, const bf16*& Bb) const {
        if (idx < 64 * 11) { pm = idx / 11; pn = idx % 11; }
        else if (idx < 64 * 11 + 8) { pm = 64 + (idx - 64 * 11); pn = 2; }
        else return false;
        Ab = A + (size_t)pm * 256 * D; Bb = Bt + (size_t)pn * 256 * D; return true;
    }
};

struct EpiZ {
    bf16* ZT;
    __device__ __forceinline__ void st(int ch, int tok, const float* v) const { *(v4u*)(ZT + ((size_t)((tok >> 11) * 1536 + ch)) * 2048 + (tok & 2047)) = pack8(v); }
    __device__ __forceinline__ void operator()(int row, int pn, int c8, const float* v0, const float* v1) const { st(row, pn * 256 + c8, v0); st(row, pn * 256 + 128 + c8, v1); }
};
struct EpiIn {
    bf16 *Q, *Kr, *V, *KC, *VC; unsigned char *GA, *GB;
    __device__ __forceinline__ void one(int row, int n, const float* v) const {
        if (n < OFF_K) { if (row < M) *(v4u*)(Q + (size_t)row * QW + (n - OFF_Q)) = pack8(v); }
        else if (n < OFF_V) { if (row < M) *(v4u*)(Kr + (size_t)row * KVW + (n - OFF_K)) = pack8(v); else *(v4u*)(KC + (size_t)(row - M) * KVW + (n - OFF_K)) = pack8(v); }
        else if (n < OFF_G) { if (row < M) *(v4u*)(V + (size_t)row * KVW + (n - OFF_V)) = pack8(v); else *(v4u*)(VC + (size_t)(row - M) * KVW + (n - OFF_V)) = pack8(v); }
        else if (row < M) {
            unsigned q[8];
#pragma unroll
            for (int j = 0; j < 8; ++j) q[j] = (unsigned)(sigmf(v[j]) * 255.f + 0.5f);
            v2u w; w.x = q[0] | (q[1] << 8) | (q[2] << 16) | (q[3] << 24); w.y = q[4] | (q[5] << 8) | (q[6] << 16) | (q[7] << 24);
            if (n < OFF_G + D) *(v2u*)(GA + (size_t)row * D + (n - OFF_G)) = w; else *(v2u*)(GB + (size_t)row * D + (n - OFF_G - D)) = w;
        }
    }
    __device__ __forceinline__ void operator()(int row, int pn, int c8, const float* v0, const float* v1) const { one(row, OFF_Q + pn * 256 + c8, v0); one(row, OFF_Q + pn * 256 + 128 + c8, v1); }
};
struct EpiT1 {
    const unsigned char* GA; bf16* TA;
    __device__ __forceinline__ void one(int row, int n, const float* v) const {
        float g[8], o[8]; unpack8_u8(*(const v2u*)(GA + (size_t)row * D + n), g);
#pragma unroll
        for (int j = 0; j < 8; ++j) o[j] = g[j] * v[j];
        *(v4u*)(TA + (size_t)row * D + n) = pack8(o);
    }
    __device__ __forceinline__ void operator()(int row, int pn, int c8, const float* v0, const float* v1) const { one(row, pn * 256 + c8, v0); one(row, pn * 256 + 128 + c8, v1); }
};
struct EpiT2 {
    const unsigned char* GB; const bf16* TA; bf16* MMo;
    __device__ __forceinline__ void one(int row, int n, const float* v) const {
        float g[8], t[8], o[8]; unpack8_u8(*(const v2u*)(GB + (size_t)row * D + n), g); unpack8(*(const v4u*)(TA + (size_t)row * D + n), t);
#pragma unroll
        for (int j = 0; j < 8; ++j) o[j] = t[j] + g[j] * v[j];
        *(v4u*)(MMo + (size_t)row * D + n) = pack8(o);
    }
    __device__ __forceinline__ void operator()(int row, int pn, int c8, const float* v0, const float* v1) const { one(row, pn * 256 + c8, v0); one(row, pn * 256 + 128 + c8, v1); }
};
struct EpiOut {
    const float* x; const float* mod; float* out;
    __device__ __forceinline__ void one(int row, int n, const float* v) const {
        const float* g1 = mod + (size_t)(row >> 11) * MODW + 2 * D + n; const float* xr = x + (size_t)row * D + n; float* o = out + (size_t)row * D + n;
        const f32x4 x0 = *(const f32x4*)xr, x1 = *(const f32x4*)(xr + 4), ga = *(const f32x4*)g1, gb = *(const f32x4*)(g1 + 4);
        f32x4 o0, o1;
#pragma unroll
        for (int j = 0; j < 4; ++j) { o0[j] = x0[j] + ga[j] * v[j]; o1[j] = x1[j] + gb[j] * v[4 + j]; }
        *(f32x4*)o = o0; *(f32x4*)(o + 4) = o1;
    }
    __device__ __forceinline__ void operator()(int row, int pn, int c8, const float* v0, const float* v1) const { one(row, pn * 256 + c8, v0); one(row, pn * 256 + 128 + c8, v1); }
};
struct EpiH {
    unsigned char* HB;
    __device__ __forceinline__ void operator()(int row, int pn, int c8, const float* v0, const float* v1) const {
        float o[8];
#pragma unroll
        for (int j = 0; j < 8; ++j) o[j] = siluf(v0[j]) * v1[j];
        v2u w; w.x = pk4_fp8(o[0], o[1], o[2], o[3]); w.y = pk4_fp8(o[4], o[5], o[6], o[7]);
        *(v2u*)(HB + (size_t)row * DFF + pn * 128 + c8) = w;
    }
};
struct EpiY {
    const float* selg; const float* mod; unsigned char* Y;
    __device__ __forceinline__ void one(int row, int n, const float* v) const {
        const float g = selg[row] * 32.f; const float* g2 = mod + (size_t)((row >> 8) & 7) * MODW + 5 * D + n; float o[8];
#pragma unroll
        for (int j = 0; j < 8; ++j) o[j] = v[j] * g * g2[j];
        v2u w; w.x = pk4_fp8(o[0], o[1], o[2], o[3]); w.y = pk4_fp8(o[4], o[5], o[6], o[7]);
        *(v2u*)(Y + (size_t)row * D + n) = w;
    }
    __device__ __forceinline__ void operator()(int row, int pn, int c8, const float* v0, const float* v1) const { one(row, pn * 256 + c8, v0); one(row, pn * 256 + 128 + c8, v1); }
};
template <class F> struct K0 { F f; __device__ __forceinline__ void operator()(int kind, int row, int pn, int c8, const float* v0, const float* v1) const { f(row, pn, c8, v0, v1); } };
struct EpiP5 { EpiT1 t1; EpiT2 t2;
    __device__ __forceinline__ void operator()(int kind, int row, int pn, int c8, const float* v0, const float* v1) const { if (kind == 0) t1(row, pn, c8, v0, v1); else t2(row, pn, c8, v0, v1); } };
struct EpiP2 { EpiZ z; EpiIn in;
    __device__ __forceinline__ void operator()(int kind, int row, int pn, int c8, const float* v0, const float* v1) const { if (kind == 0) z(row, pn, c8, v0, v1); else in(row, pn, c8, v0, v1); } };

struct TrItem { const float* W; bf16* WT; int N, ldt, k0, n0, drow0, fp8; };
__device__ __forceinline__ void tr_load(const TrItem& T, int lane, f32x4 (&v)[8]) {
    const float* p = T.W + (size_t)(T.k0 + 8 * (lane & 7)) * T.N + T.n0 + 4 * (lane >> 3);
#pragma unroll
    for (int j = 0; j < 8; ++j) v[j] = __builtin_nontemporal_load((const f32x4*)(p + (size_t)j * T.N));
}
__device__ __forceinline__ void tr_store(const TrItem& T, int lane, const f32x4 (&v)[8]) {
    if (T.fp8) {
        unsigned char* q = (unsigned char*)T.WT + (size_t)(T.drow0 + 4 * (lane >> 3)) * T.ldt + T.k0 + 8 * (lane & 7);
#pragma unroll
        for (int i = 0; i < 4; ++i) { v2u o; o.x = pk4_fp8(32.f * v[0][i], 32.f * v[1][i], 32.f * v[2][i], 32.f * v[3][i]); o.y = pk4_fp8(32.f * v[4][i], 32.f * v[5][i], 32.f * v[6][i], 32.f * v[7][i]);
            *(v2u*)(q + (size_t)i * T.ldt) = o; }
    } else {
        bf16* q = T.WT + (size_t)(T.drow0 + 4 * (lane >> 3)) * T.ldt + T.k0 + 8 * (lane & 7);
#pragma unroll
        for (int i = 0; i < 4; ++i) { v4u o; o.x = pk2(v[0][i], v[1][i]); o.y = pk2(v[2][i], v[3][i]); o.z = pk2(v[4][i], v[5][i]); o.w = pk2(v[6][i], v[7][i]);
            *(v4u*)(q + (size_t)i * T.ldt) = o; }
    }
}
constexpr int TR_NITEMS = (D / 64) * (INW / 32) + 2 * (HW / 64) * (D / 32) + (D / 64) * (D / 32) + NE * (2 * (D / 64) * (DFF / 32) + (DFF / 64) * (D / 32));
constexpr int TR_TAIL = 112 * NWAVES * 8;
constexpr int TR_SL_HY = 256 * NWAVES * 16;
constexpr int TR_SL_AT = 0;
constexpr int TR_SL_RP = 0;
constexpr int TR_SL_TT = 0;
constexpr int TR_SL_TK = 256 * NWAVES * 2;
constexpr int TR_P0 = TR_NITEMS - TR_TAIL - TR_SL_HY - TR_SL_AT - TR_SL_RP - TR_SL_TT - TR_SL_TK, TR_HY0 = TR_P0, TR_AT0 = TR_HY0 + TR_SL_HY, TR_RP0 = TR_AT0 + TR_SL_AT, TR_TT0 = TR_RP0 + TR_SL_RP, TR_TK0 = TR_TT0 + TR_SL_TT;
static_assert(TR_P0 >= (D / 64) * (INW / 32) + 2 * (HW / 64) * (D / 32) + (D / 64) * (D / 32), "prologue slice covers the non-expert weights");
__device__ __forceinline__ bool tr_item(const Ctx& C, int it, TrItem& T) {
    constexpr int I_IN = (D / 64) * (INW / 32), I_A = (HW / 64) * (D / 32), I_O = (D / 64) * (D / 32), I_G = (D / 64) * (DFF / 32), I_D = (DFF / 64) * (D / 32);
    constexpr int NITEMS = I_IN + 2 * I_A + I_O + NE * (2 * I_G + I_D);
    if (it >= NITEMS || it < 0) return false;
    int r = it;
    if (r < I_IN) { const int nblk = INW / 32, kb = r / nblk, nbk = r % nblk;
        if (nbk * 32 < OFF_G) T = TrItem{C.in[IN_WIN], (bf16*)(C.ws + WS_WINT), INW, D, kb * 64, nbk * 32, nbk * 32, 0};
        else T = TrItem{C.in[IN_WIN], (bf16*)(C.ws + WS_WG8), INW, D, kb * 64, nbk * 32, nbk * 32 - OFF_G, 1};
        return true; } r -= I_IN;
    if (r < I_A) { const int nblk = D / 32, kb = r / nblk, nbk = r % nblk; T = TrItem{C.in[IN_WA], (bf16*)(C.ws + WS_WAT), D, HW, kb * 64, nbk * 32, nbk * 32, 0}; return true; } r -= I_A;
    if (r < I_A) { const int nblk = D / 32, kb = r / nblk, nbk = r % nblk; T = TrItem{C.in[IN_WB], (bf16*)(C.ws + WS_WBT), D, HW, kb * 64, nbk * 32, nbk * 32, 0}; return true; } r -= I_A;
    if (r < I_O) { const int nblk = D / 32, kb = r / nblk, nbk = r % nblk; T = TrItem{C.in[IN_WOUT], (bf16*)(C.ws + WS_WOUTT), D, D, kb * 64, nbk * 32, nbk * 32, 0}; return true; } r -= I_O;
    const int e = r / (2 * I_G + I_D); r -= e * (2 * I_G + I_D);
    if (r < 2 * I_G) { const int which = r / I_G; r -= which * I_G; const int nblk = DFF / 32, kb = r / nblk, nbk = r % nblk, f0 = nbk * 32;
        T = TrItem{(which ? C.in[IN_WUP] : C.in[IN_WGATE]) + (size_t)e * D * DFF, (bf16*)(C.ws + WS_W1T), DFF, D, kb * 64, f0, e * 4096 + 256 * (f0 >> 7) + 128 * which + (f0 & 127), 1}; return true; }
    r -= 2 * I_G;
    { const int nblk = D / 32, kb = r / nblk, nbk = r % nblk; T = TrItem{C.in[IN_WDOWN] + (size_t)e * DFF * D, (bf16*)(C.ws + WS_W2T), D, DFF, kb * 64, nbk * 32, e * 1024 + nbk * 32, 1}; return true; }
}
struct ConvSlice { int it, left; };
__device__ __forceinline__ ConvSlice conv_slice(const Ctx& C, int base, int per_wave) { ConvSlice q; q.it = base + (C.bid * NWAVES + C.wave) * per_wave; q.left = (C.nb == 256) ? per_wave : 0; return q; }
__device__ __forceinline__ void conv_flush(const Ctx& C, ConvSlice& q) {
    while (q.left > 0) { TrItem T; f32x4 v[8]; tr_item(C, q.it, T); tr_load(T, C.lane, v); tr_store(T, C.lane, v); q.it += 1; q.left -= 1; }
}

__device__ __forceinline__ void hx_rows(const Ctx& C);
__device__ __forceinline__ void p0_phase(const Ctx& C) {
    const int gw = C.bid * NWAVES + C.wave, NGW = C.nb * NWAVES, lane = C.lane;
    float* mod = (float*)(C.ws + WS_MOD);
    {
        LAS float* sc = (LAS float*)C.lds;
        LAS float* red = sc + 9 * 1024;
        for (int i = C.tid; i < 9 * 1024; i += NT) { const float v = (i < 8 * 1024) ? C.in[IN_C][i] : C.in[IN_CCTX][i - 8 * 1024]; sc[i] = siluf(v); }
        __syncthreads();
        for (int cb = C.bid; cb < MODW / 32; cb += C.nb) {
            const int cl = C.tid & 31, kg = C.tid >> 5, n = cb * 32 + cl;
            float a[9];
#pragma unroll
            for (int r = 0; r < 9; ++r) a[r] = 0.f;
#pragma unroll 1
            for (int k0 = kg; k0 < D; k0 += 16 * 16) {
                float w[16];
#pragma unroll
                for (int u = 0; u < 16; ++u) w[u] = __builtin_nontemporal_load(C.in[IN_ADAW] + (size_t)(k0 + 16 * u) * MODW + n);
#pragma unroll
                for (int u = 0; u < 16; ++u)
#pragma unroll
                    for (int r = 0; r < 9; ++r) a[r] += sc[r * 1024 + k0 + 16 * u] * w[u];
            }
#pragma unroll
            for (int r = 0; r < 9; ++r) red[(kg * 9 + r) * 32 + cl] = a[r];
            __syncthreads();
            if (C.tid < 9 * 32) { const int r = C.tid >> 5, c2 = C.tid & 31; float s = 0.f;
                for (int g = 0; g < 16; ++g) s += red[(g * 9 + r) * 32 + c2];
                mod[(size_t)r * MODW + cb * 32 + c2] = s + C.in[IN_ADAB][cb * 32 + c2]; }
            __syncthreads();
        }
    }
    sb_arrive((unsigned*)(C.ws + WS_CTL) + CW_SB0);
    {
        float* H3 = (float*)(C.ws + WS_H3);
        const double PI2 = 6.283185307179586476925286766559;
        for (int pos = gw; pos < L; pos += NGW) {
            double feat = 0.0;
            {
                const double t = (double)pos / (double)(L - 1), w = PI2 * (double)pos / (double)L;
                if (lane == 0) feat = t;
                else if (lane <= 32) { const int b = (lane - 1) & 15; const double fr = 1e-4 + (15.0 - 1e-4) * (double)b / 15.0; feat = (lane <= 16) ? cos(fr * w) : -sin(fr * w); }
            }
            const double fq = (double)C.in[IN_FFREQ][lane];
            double acc = (double)C.in[IN_FB1][lane];
            for (int k = 0; k < 33; ++k) acc += __shfl(feat, k) * (double)C.in[IN_FW1][k * 64 + lane];
            double h = sin(fq * acc);
            acc = (double)C.in[IN_FB2][lane];
            for (int k = 0; k < 64; ++k) acc += __shfl(h, k) * (double)C.in[IN_FW2][k * 64 + lane];
            h = sin(fq * acc);
            acc = (double)C.in[IN_FB3][lane];
            for (int k = 0; k < 64; ++k) acc += __shfl(h, k) * (double)C.in[IN_FW3][k * 64 + lane];
            h = sin(fq * acc);
            H3[(size_t)lane * L + pos] = (float)h;
        }
    }
    {
        float* R = (float*)(C.ws + WS_ROPE);
        for (int i = C.bid * NT + C.tid; i < L * 32; i += C.nb * NT) {
            const int pos = i >> 5, a = i & 31; const int m = a & 15;
            const double inv = pow(10000.0, -(double)m / 16.0);
            const double p = (a < 16) ? (double)(pos >> 6) : (double)(pos & 63);
            const double ang = p * inv;
            R[2 * i] = (float)cos(ang); R[2 * i + 1] = (float)sin(ang);
        }
    }
    {
        TrItem Ta, Tb; f32x4 va[8], vb[8];
        for (int it = gw; ; it += 2 * NGW) {
            const int lim = (C.nb == 256) ? TR_P0 : TR_NITEMS;
            const bool ha = (it < lim) && tr_item(C, it, Ta), hb = (it + NGW < lim) && tr_item(C, it + NGW, Tb);
            if (!ha) break;
            tr_load(Ta, lane, va); if (hb) tr_load(Tb, lane, vb);
            tr_store(Ta, lane, va); if (hb) tr_store(Tb, lane, vb);
        }
    }
    sb_wait((unsigned*)(C.ws + WS_CTL) + CW_SB0, (unsigned)C.nb, (unsigned*)(C.ws + WS_CTL) + CW_BAR + XB_TMO);
    hx_rows(C);
}

__device__ __forceinline__ void tap_table(const Ctx& C) {
    {
        const float* H3T = (const float*)(C.ws + WS_H3); bf16* GT = (bf16*)(C.ws + WS_GTAB);
        const float min_decay = -3.0701134573253946f, max_decay = -15.350567286626973f;
        ConvSlice tq = conv_slice(C, TR_TT0, 0);
        for (int c0 = C.bid; c0 < HW / 2; c0 += C.nb) {
            float a[2][4][4];
#pragma unroll
            for (int cc = 0; cc < 2; ++cc)
#pragma unroll
                for (int kk = 0; kk < 4; ++kk)
#pragma unroll
                    for (int q = 0; q < 4; ++q) a[cc][kk][q] = 0.f;
            const float* fo = C.in[IN_FOUT] + c0;
#pragma unroll 1
            for (int kq = 0; kq < 4; ++kq) {
            TrItem Ta; f32x4 cva[8]; const bool cv = tq.left > 0;
            if (cv) { tr_item(C, tq.it, Ta); tr_load(Ta, C.lane, cva); }
#pragma unroll 16
            for (int k = kq * 16; k < kq * 16 + 16; ++k) {
                float hv[4];
#pragma unroll
                for (int kk = 0; kk < 4; ++kk) hv[kk] = H3T[(size_t)k * L + C.tid + 512 * kk];
#pragma unroll
                for (int cc = 0; cc < 2; ++cc)
#pragma unroll
                    for (int q = 0; q < 4; ++q) { const float f = fo[(size_t)k * 2048 + q * 512 + cc * 256];
#pragma unroll
                        for (int kk = 0; kk < 4; ++kk) a[cc][kk][q] += hv[kk] * f; }
            }
            if (cv) { tr_store(Ta, C.lane, cva); tq.it += 1; tq.left -= 1; }
            }
#pragma unroll
            for (int cc = 0; cc < 2; ++cc) {
                const int c = c0 + cc * 256;
                const float delta = fabsf(min_decay + (max_decay - min_decay) * (float)c / 511.f);
#pragma unroll
                for (int kk = 0; kk < 4; ++kk) {
                    const int t = C.tid + 512 * kk;
                    const float dec = expf(-((float)t / (float)(L - 1)) * delta);
#pragma unroll
                    for (int o = 0; o < 2; ++o) {
                        float f = a[cc][kk][o * 2] * dec, bk = a[cc][kk][o * 2 + 1] * dec;
                        if (t == 0) f += C.in[IN_HBIAS][o * 512 + c];
                        bf16* g = GT + ((size_t)c * 2 + o) * GT_LEN;
                        g[2047 - t] = (bf16)f2bf(f); if (t == 0) g[4095] = (bf16)0; else g[2047 + t] = (bf16)f2bf(bk);
                    }
                }
            }
        }
            conv_flush(C, tq);
    }
}

__device__ __forceinline__ void hx_rows(const Ctx& C) {
    const int gw = C.bid * NWAVES + C.wave, NGW = C.nb * NWAVES, lane = C.lane;
    const float* mod = (const float*)(C.ws + WS_MOD);
    bf16* HX = (bf16*)(C.ws + WS_HX); unsigned char* HX8 = (unsigned char*)(C.ws + WS_HX8);
    for (int row0 = gw * 4; row0 < MT; row0 += NGW * 4) {
        const float* xr = (row0 < M) ? C.in[IN_X] + (size_t)row0 * D : C.in[IN_CTX] + (size_t)(row0 - M) * D;
        const int mb = (row0 < M) ? (row0 >> 11) : 8;
        const float* sh = mod + (size_t)mb * MODW; const float* sc = sh + D;
        f32x4 v[4][4]; float ss[4];
#pragma unroll
        for (int r = 0; r < 4; ++r)
#pragma unroll
            for (int j = 0; j < 4; ++j) v[r][j] = __builtin_nontemporal_load((const f32x4*)(xr + (size_t)r * D + 4 * lane + 256 * j));
#pragma unroll
        for (int r = 0; r < 4; ++r) { float s2 = 0.f;
#pragma unroll
            for (int j = 0; j < 4; ++j) s2 += (v[r][j][0] * v[r][j][0] + v[r][j][1] * v[r][j][1]) + (v[r][j][2] * v[r][j][2] + v[r][j][3] * v[r][j][3]);
            ss[r] = 1.f / sqrtf(wave_sum(s2) * (1.f / D) + EPS); }
#pragma unroll
        for (int j = 0; j < 4; ++j) {
            const int c0 = 4 * lane + 256 * j; const f32x4 g = *(const f32x4*)(C.in[IN_NORM1] + c0), a = *(const f32x4*)(sc + c0), b = *(const f32x4*)(sh + c0);
            float gm[4];
#pragma unroll
            for (int i = 0; i < 4; ++i) gm[i] = g[i] * (1.f + a[i]);
#pragma unroll
            for (int r = 0; r < 4; ++r) {
                float o[4];
#pragma unroll
                for (int i = 0; i < 4; ++i) o[i] = v[r][j][i] * ss[r] * gm[i] + b[i];
                v2u w; w.x = pk2(o[0], o[1]); w.y = pk2(o[2], o[3]);
                *(v2u*)(HX + (size_t)(row0 + r) * D + c0) = w;
                if (row0 < M) *(unsigned*)(HX8 + (size_t)(row0 + r) * D + c0) = pk4_fp8(o[0], o[1], o[2], o[3]);
            }
        }
    }
}
__device__ __forceinline__ void p1_phase(const Ctx& C) { if (C.nb != 256) tap_table(C); }

__device__ __forceinline__ float conv3(const bf16* u, int t, float w0, float w1, float w2, float cb) {
    const float a = (t > 0) ? bf2f(u[t - 1]) : 0.f, b = bf2f(u[t]), c = (t < L - 1) ? bf2f(u[t + 1]) : 0.f;
    return a * w0 + b * w1 + c * w2 + cb;
}
__device__ __forceinline__ void hyena_naive(const Ctx& C, int c) {
    const bf16* ZT = (const bf16*)(C.ws + WS_ZT); const bf16* GT = (const bf16*)(C.ws + WS_GTAB); bf16* YA = (bf16*)(C.ws + WS_YA);
    LAS float* G = (LAS float*)C.lds;
    LAS bf16* y0 = (LAS bf16*)(G + 4096);
    LAS bf16* y1 = y0 + 8 * 2048;
    const float* cw = C.in[IN_CONVW]; const float* cb = C.in[IN_CONVB];
    __syncthreads();
    for (int i = C.tid; i < 8 * 2048; i += NT) { const int b = i >> 11, t = i & 2047;
        y0[i] = (bf16)f2bf(conv3(ZT + ((size_t)b * 1536 + c) * 2048, t, cw[c], cw[1536 + c], cw[3072 + c], cb[c])); }
    for (int o = 0; o < 2; ++o) {
        LAS bf16* yi = o ? y1 : y0;
        for (int i = C.tid; i < 4096; i += NT) G[i] = bf2f(GT[((size_t)c * 2 + o) * GT_LEN + 4095 - i]);
        __syncthreads();
        const int gc = 512 * (o + 1) + c;
        float acc[4][8];
#pragma unroll
        for (int k = 0; k < 4; ++k)
#pragma unroll
            for (int b = 0; b < 8; ++b) acc[k][b] = 0.f;
        for (int s = 0; s < L; ++s) {
            float yv[8];
#pragma unroll
            for (int b = 0; b < 8; ++b) yv[b] = bf2f(yi[b * 2048 + s]);
#pragma unroll
            for (int k = 0; k < 4; ++k) { const float g = G[2048 + C.tid + 512 * k - s];
#pragma unroll
                for (int b = 0; b < 8; ++b) acc[k][b] += g * yv[b]; }
        }
#pragma unroll
        for (int k = 0; k < 4; ++k)
#pragma unroll
            for (int b = 0; b < 8; ++b) { const int t = C.tid + 512 * k;
                const float gate = conv3(ZT + ((size_t)b * 1536 + gc) * 2048, t, cw[gc], cw[1536 + gc], cw[3072 + gc], cb[gc]);
                const float r = gate * acc[k][b];
                if (o == 0) y1[b * 2048 + t] = (bf16)f2bf(r); else YA[((size_t)b * 2048 + t) * HW + c] = (bf16)f2bf(r); }
        __syncthreads();
    }
}


typedef float f32x16 __attribute__((ext_vector_type(16)));
constexpr int HY_YROW = 4496, HY_Y0 = 0, HY_Y1 = 35968, HY_TAP = 71936, HY_CS = 8256, HY_TMP = 137984;
static_assert(HY_TMP + 8192 + 16 <= MISC_OFF, "hyena LDS map");
template <int ORDER>
__device__ __forceinline__ void hyena_conv(const Ctx& C, int c, ConvSlice& cq) {
    const bf16* ZT = (const bf16*)(C.ws + WS_ZT); bf16* YAT = (bf16*)(C.ws + WS_YAT);
    const float* cw = C.in[IN_CONVW]; const float* cbp = C.in[IN_CONVB];
    const int w = C.wave, lane = C.lane, p = lane & 31, h = lane >> 5;
    const int m = 7 - (p & 7), pa = p >> 3, il = p & 3, b = p >> 2;
    const int yin = ORDER ? HY_Y1 : HY_Y0;
    const int dlo = 8 * w - 63;
    const int I0 = 2 * w;
    const int gc = 512 * (ORDER + 1) + c;
    const bf16* ug = ZT + ((size_t)b * 1536 + gc) * 2048;
    v2u gmid[2][4]; unsigned ghalo[2][4];
#pragma unroll
    for (int tile = 0; tile < 2; ++tile)
#pragma unroll
        for (int g = 0; g < 4; ++g) {
            const int t0 = 32 * (4 * (I0 + tile) + il) + 8 * g + 4 * h;
            gmid[tile][g] = *(const v2u*)(ug + t0);
            { const unsigned short x = ug[t0 > 0 ? t0 - 1 : 0], y = ug[t0 + 4 < L ? t0 + 4 : L - 1]; ghalo[tile][g] = ((t0 > 0) ? (unsigned)x : 0u) | (((t0 + 4 < L) ? (unsigned)y : 0u) << 16); }
        }
    TrItem Ta; f32x4 cva[8]; bool cv = cq.left >= 1;
    if (cv) { tr_item(C, cq.it, Ta); tr_load(Ta, lane, cva); }
    const LAS unsigned char* ap = C.lds + HY_TAP + m * HY_CS + 16 * (255 - pa + h) - 64 * dlo;
    const LAS unsigned char* bp0 = C.lds + yin + b * HY_YROW + 2 * (96 + 32 * (4 * I0 + il) + 8 * h) - 64 * dlo;
    f32x16 acc0, acc1;
#pragma unroll
    for (int i = 0; i < 16; ++i) { acc0[i] = 0.f; acc1[i] = 0.f; }
#define HY_LD(p) (*(const LAS bf16x8*)(p))
#define HY_MMA(a, b, c) c = __builtin_amdgcn_mfma_f32_32x32x16_bf16(a, b, c, 0, 0, 0)
#define HY_STEPA { const bf16x8 a0 = HY_LD(ap), a1 = HY_LD(ap + 32), b0 = HY_LD(bp0), b1 = HY_LD(bp0 + 32); HY_MMA(a0, b0, acc0); HY_MMA(a1, b1, acc0); ap -= 64; bp0 -= 64; }
#define HY_STEPB { const bf16x8 a0 = HY_LD(ap), a1 = HY_LD(ap + 32), n0 = HY_LD(bp0), n1 = HY_LD(bp0 + 32), m0 = HY_LD(bp0 + 256), m1 = HY_LD(bp0 + 288); \
        HY_MMA(a0, n0, acc0); HY_MMA(a0, m0, acc1); HY_MMA(a1, n1, acc0); HY_MMA(a1, m1, acc1); ap -= 64; bp0 -= 64; }
#define HY_STEPC { const bf16x8 a0 = HY_LD(ap), a1 = HY_LD(ap + 32), m0 = HY_LD(bp0 + 256), m1 = HY_LD(bp0 + 288); HY_MMA(a0, m0, acc1); HY_MMA(a1, m1, acc1); ap -= 64; bp0 -= 64; }
    HY_STEPA HY_STEPA HY_STEPA HY_STEPA
    if (!(C.sub & 16)) {
#pragma unroll 1
    for (int it = 0; it < 21; ++it) {
        if ((it == 5 || it == 10 || it == 15) && cv) { tr_store(Ta, lane, cva); cq.it += 1; cq.left -= 1; cv = cq.left >= 1; if (cv) { tr_item(C, cq.it, Ta); tr_load(Ta, lane, cva); } }
        HY_STEPB HY_STEPB HY_STEPB }
    }
    HY_STEPC HY_STEPC HY_STEPC HY_STEPC
#undef HY_LD
#undef HY_MMA
#undef HY_STEPA
#undef HY_STEPB
#undef HY_STEPC
    if (cv) { tr_store(Ta, lane, cva); cq.it += 1; cq.left -= 1; }
    if (C.sub & 64) return;
    const float w0 = cw[gc], w1 = cw[1536 + gc], w2 = cw[3072 + gc], cb = cbp[gc];
#pragma unroll
    for (int tile = 0; tile < 2; ++tile) {
#pragma unroll
        for (int g = 0; g < 4; ++g) {
            const int t0 = 32 * (4 * (I0 + tile) + il) + 8 * g + 4 * h;
            const v2u mid = gmid[tile][g];
            const float um1 = bflo(ghalo[tile][g]), up4 = bfhi(ghalo[tile][g]);
            const float u0 = bflo(mid.x), u1 = bfhi(mid.x), u2 = bflo(mid.y), u3 = bfhi(mid.y);
            float r[4];
            r[0] = (um1 * w0 + u0 * w1 + u1 * w2 + cb) * (tile ? acc1[4 * g + 0] : acc0[4 * g + 0]);
            r[1] = (u0 * w0 + u1 * w1 + u2 * w2 + cb) * (tile ? acc1[4 * g + 1] : acc0[4 * g + 1]);
            r[2] = (u1 * w0 + u2 * w1 + u3 * w2 + cb) * (tile ? acc1[4 * g + 2] : acc0[4 * g + 2]);
            r[3] = (u2 * w0 + u3 * w1 + up4 * w2 + cb) * (tile ? acc1[4 * g + 3] : acc0[4 * g + 3]);
            v2u o; o.x = pk2(r[0], r[1]); o.y = pk2(r[2], r[3]);
            if (ORDER == 0) *(LAS v2u*)(C.lds + HY_Y1 + b * HY_YROW + 2 * (96 + t0)) = o;
            else *(v2u*)(YAT + ((size_t)c * 8 + b) * 2048 + t0) = o;
        }
    }
}
struct HyPre { v4u u[4]; unsigned short um1[4], up8[4]; v4u taps; };
__device__ __forceinline__ void hyena_prefetch(const Ctx& C, int c, HyPre& P) {
    const bf16* ZT = (const bf16*)(C.ws + WS_ZT); const bf16* GT = (const bf16*)(C.ws + WS_GTAB);
#pragma unroll
    for (int k = 0; k < 4; ++k) {
        const int ci = C.tid + 512 * k, b = ci >> 8, t0 = (ci & 255) * 8;
        const bf16* u = ZT + ((size_t)b * 1536 + c) * 2048;
        P.u[k] = *(const v4u*)(u + t0); { const unsigned short x = u[t0 > 0 ? t0 - 1 : 0], y = u[t0 + 8 < L ? t0 + 8 : L - 1]; P.um1[k] = (t0 > 0) ? x : (unsigned short)0; P.up8[k] = (t0 + 8 < L) ? y : (unsigned short)0; }
    }
    P.taps = *(const v4u*)(GT + ((size_t)c * 2 + 0) * GT_LEN + C.tid * 8);
}
__device__ __forceinline__ void hyena_taps_fill(const Ctx& C, v4u traw) {
    LAS unsigned char* tmp = C.lds + HY_TMP;
    *(LAS v4u*)(tmp + C.tid * 16) = traw;
    if (C.tid == 0) *(LAS v4u*)(tmp + 8192) = (v4u){0u, 0u, 0u, 0u};
    LDS_BARRIER();
    const v4u hi = *(const LAS v4u*)(tmp + C.tid * 16 + 16);
    const unsigned d[8] = {traw.x, traw.y, traw.z, traw.w, hi.x, hi.y, hi.z, hi.w};
#pragma unroll
    for (int m = 0; m < 8; ++m) {
        v4u w;
        if (m & 1) { w.x = __builtin_amdgcn_alignbit(d[(m >> 1) + 1], d[(m >> 1)], 16); w.y = __builtin_amdgcn_alignbit(d[(m >> 1) + 2], d[(m >> 1) + 1], 16);
                     w.z = __builtin_amdgcn_alignbit(d[(m >> 1) + 3], d[(m >> 1) + 2], 16); w.w = __builtin_amdgcn_alignbit(d[(m >> 1) + 4], d[(m >> 1) + 3], 16); }
        else { w.x = d[m >> 1]; w.y = d[(m >> 1) + 1]; w.z = d[(m >> 1) + 2]; w.w = d[(m >> 1) + 3]; }
        *(LAS v4u*)(C.lds + HY_TAP + m * HY_CS + C.tid * 16) = w;
    }
    LDS_BARRIER();
}
__device__ __forceinline__ void hyena_fast(const Ctx& C, int c, int cnext, ConvSlice& cq) {
    HyPre P; hyena_prefetch(C, c, P);
    const bf16* GT = (const bf16*)(C.ws + WS_GTAB);
    const float* cw = C.in[IN_CONVW]; const float* cbp = C.in[IN_CONVB];
    LDS_BARRIER();
    {
        const float w0 = cw[c], w1 = cw[1536 + c], w2 = cw[3072 + c], cb = cbp[c];
#pragma unroll
        for (int k = 0; k < 4; ++k) {
            const int ci = C.tid + 512 * k, b = ci >> 8, t0 = (ci & 255) * 8;
            float f[10]; unpack8(P.u[k], f + 1);
            f[0] = bf2f(P.um1[k]); f[9] = bf2f(P.up8[k]);
            float o[8];
#pragma unroll
            for (int j = 0; j < 8; ++j) o[j] = f[j] * w0 + f[j + 1] * w1 + f[j + 2] * w2 + cb;
            *(LAS v4u*)(C.lds + HY_Y0 + b * HY_YROW + 2 * (96 + t0)) = pack8(o);
        }
    }
    const v4u t1raw = *(const v4u*)(GT + ((size_t)c * 2 + 1) * GT_LEN + C.tid * 8);
    if (!(C.sub & 32)) hyena_taps_fill(C, P.taps);
    hyena_conv<0>(C, c, cq);
    LDS_BARRIER();
    if (!(C.sub & 32)) hyena_taps_fill(C, t1raw);
    hyena_conv<1>(C, c, cq);
}
__device__ __forceinline__ void hyena_zero_pads(const Ctx& C) {
    for (int i = C.tid; i < 2 * 8 * 100; i += NT) {
        const int buf = i / 800, r = (i % 800) / 100, k = i % 100;
        const int e = (k < 48) ? 2 * k : 2144 + 2 * (k - 48);
        *(LAS unsigned*)(C.lds + (buf ? HY_Y1 : HY_Y0) + r * HY_YROW + 2 * e) = 0u;
    }
    __syncthreads();
}

__device__ __forceinline__ void attn_naive(const Ctx& C, int item) {
    const int b = item >> 5, kvh = (item >> 4) & 1, qb = item & 15;
    const bf16* Q = (const bf16*)(C.ws + WS_QRAW); const bf16* Kr = (const bf16*)(C.ws + WS_KRAW); const bf16* V = (const bf16*)(C.ws + WS_VB);
    const bf16* KC = (const bf16*)(C.ws + WS_KC); const bf16* VC = (const bf16*)(C.ws + WS_VC); bf16* YB = (bf16*)(C.ws + WS_YB);
    const float* rope = (const float*)(C.ws + WS_ROPE);
    LAS float* Ks = (LAS float*)C.lds;
    LAS float* Vs = Ks + 128 * 64;
    const int g = C.tid >> 7, qi = C.tid & 127, h = kvh * 4 + g, t = qb * 128 + qi;
    float q[64];
    {
        const bf16* qr = Q + ((size_t)b * L + t) * QW + h * 64; float ss = 0.f;
#pragma unroll
        for (int j = 0; j < 8; ++j) { unpack8(*(const v4u*)(qr + 8 * j), q + 8 * j); }
#pragma unroll
        for (int d = 0; d < 64; ++d) ss += q[d] * q[d];
        const float rs = 1.f / sqrtf(ss * (1.f / 64.f) + EPS);
#pragma unroll
        for (int i = 0; i < 32; ++i) { const float cs = rope[((size_t)t * 32 + i) * 2], sn = rope[((size_t)t * 32 + i) * 2 + 1];
            const float xe = q[2 * i] * rs * C.in[IN_QNORM][2 * i], xo = q[2 * i + 1] * rs * C.in[IN_QNORM][2 * i + 1];
            q[2 * i] = rbf((xe * cs - xo * sn) * 0.125f); q[2 * i + 1] = rbf((xe * sn + xo * cs) * 0.125f); }
    }
    float mrun = -1e30f, lrun = 0.f, o[64];
#pragma unroll
    for (int d = 0; d < 64; ++d) o[d] = 0.f;
    for (int ch = 0; ch < 5; ++ch) {
        const int kblk = qb - 1 + ch;
        if (ch < 3 && (kblk < 0 || kblk >= 16)) continue;
        __syncthreads();
        {
            const int key = C.tid >> 2, part = C.tid & 3;
            const bf16* kr; const bf16* vr; int pos = 0;
            if (ch < 3) { pos = kblk * 128 + key; kr = Kr + ((size_t)b * L + pos) * KVW + kvh * 64 + part * 16; vr = V + ((size_t)b * L + pos) * KVW + kvh * 64 + part * 16; }
            else { const int cp = (ch - 3) * 128 + key; kr = KC + ((size_t)b * LC + cp) * KVW + kvh * 64 + part * 16; vr = VC + ((size_t)b * LC + cp) * KVW + kvh * 64 + part * 16; }
            float kf[16], vf[16];
            unpack8(*(const v4u*)kr, kf); unpack8(*(const v4u*)(kr + 8), kf + 8); unpack8(*(const v4u*)vr, vf); unpack8(*(const v4u*)(vr + 8), vf + 8);
            float ss = 0.f;
#pragma unroll
            for (int d = 0; d < 16; ++d) ss += kf[d] * kf[d];
            ss += __shfl_xor(ss, 1); ss += __shfl_xor(ss, 2);
            const float rs = 1.f / sqrtf(ss * (1.f / 64.f) + EPS);
#pragma unroll
            for (int i = 0; i < 8; ++i) {
                const int pi = part * 8 + i;
                float xe = kf[2 * i] * rs * C.in[IN_KNORM][2 * pi], xo = kf[2 * i + 1] * rs * C.in[IN_KNORM][2 * pi + 1];
                if (ch < 3) { const float cs = rope[((size_t)pos * 32 + pi) * 2], sn = rope[((size_t)pos * 32 + pi) * 2 + 1]; const float a = xe * cs - xo * sn, bb = xe * sn + xo * cs; xe = a; xo = bb; }
                Ks[key * 64 + part * 16 + 2 * i] = rbf(xe); Ks[key * 64 + part * 16 + 2 * i + 1] = rbf(xo);
            }
#pragma unroll
            for (int d = 0; d < 16; ++d) Vs[key * 64 + part * 16 + d] = vf[d];
        }
        __syncthreads();
        for (int key = 0; key < 128; ++key) {
            if (ch < 3) { const int s = kblk * 128 + key; const int df = t - s; if (df > 128 || df < -128) continue; }
            float sc = 0.f;
#pragma unroll
            for (int d = 0; d < 64; ++d) sc += q[d] * Ks[key * 64 + d];
            const float mn = fmaxf(mrun, sc), al = __expf(mrun - mn), p = __expf(sc - mn);
            lrun = lrun * al + p; mrun = mn;
#pragma unroll
            for (int d = 0; d < 64; ++d) o[d] = o[d] * al + p * Vs[key * 64 + d];
        }
    }
    {
        const float sk = C.in[IN_SINK][h]; const float mn = fmaxf(mrun, sk), al = __expf(mrun - mn);
        lrun = lrun * al + __expf(sk - mn); const float inv = al / lrun;
        bf16* yr = YB + ((size_t)b * L + t) * QW + h * 64;
#pragma unroll
        for (int j = 0; j < 8; ++j) { float v[8];
#pragma unroll
            for (int d = 0; d < 8; ++d) v[d] = o[8 * j + d] * inv;
            *(v4u*)(yr + 8 * j) = pack8(v); }
    }
}


__device__ __forceinline__ void ya_transpose(const Ctx& C) {
    const bf16* YAT = (const bf16*)(C.ws + WS_YAT); bf16* YA = (bf16*)(C.ws + WS_YA);
    constexpr int RS = 144;
    for (int blk = C.bid; blk < M / 64; blk += C.nb) {
        const int tok0 = blk * 64, b = tok0 >> 11, t0 = tok0 & 2047;
        __syncthreads();
#pragma unroll
        for (int p = 0; p < 8; ++p) { const int c = (C.tid >> 3) + 64 * p, seg = C.tid & 7;
            *(LAS v4u*)(C.lds + c * RS + seg * 16) = *(const v4u*)(YAT + ((size_t)c * 8 + b) * 2048 + t0 + 8 * seg); }
        __syncthreads();
#pragma unroll 2
        for (int k = 0; k < 8; ++k) { const int tt = C.wave + 8 * k; unsigned e[8];
#pragma unroll
            for (int j = 0; j < 8; ++j) e[j] = *(const LAS bf16*)(C.lds + (8 * C.lane + j) * RS + tt * 2);
            v4u w; w.x = e[0] | (e[1] << 16); w.y = e[2] | (e[3] << 16); w.z = e[4] | (e[5] << 16); w.w = e[6] | (e[7] << 16);
            *(v4u*)(YA + (size_t)(tok0 + tt) * HW + 8 * C.lane) = w; }
    }
}

constexpr int AT_KS = 0, AT_KROW = 144, AT_VT = 128 * 144, AT_VROW = 264;
__device__ __forceinline__ void attn_fast(const Ctx& C, int item) {
    const int b = item >> 5, kvh = (item >> 4) & 1, qb = item & 15;
    const bf16* Q = (const bf16*)(C.ws + WS_QRAW); const bf16* Kr = (const bf16*)(C.ws + WS_KRAW); const bf16* V = (const bf16*)(C.ws + WS_VB);
    const bf16* KC = (const bf16*)(C.ws + WS_KC); const bf16* VC = (const bf16*)(C.ws + WS_VC); bf16* YB = (bf16*)(C.ws + WS_YB);
    const float* rope = (const float*)(C.ws + WS_ROPE);
    const int w = C.wave, g = w >> 1, qh = w & 1, hd = kvh * 4 + g, lane = C.lane, q = lane & 31, h = lane >> 5;
    bf16x8 qf[2][4];
#pragma unroll
    for (int qt = 0; qt < 2; ++qt) {
        const int t = qb * 128 + qh * 64 + qt * 32 + q;
        const bf16* qr = Q + ((size_t)b * L + t) * QW + hd * 64;
        float x[32]; float ss = 0.f;
#pragma unroll
        for (int ks = 0; ks < 4; ++ks) unpack8(*(const v4u*)(qr + 16 * ks + 8 * h), x + 8 * ks);
#pragma unroll
        for (int i = 0; i < 32; ++i) ss += x[i] * x[i];
        ss += __shfl_xor(ss, 32);
        const float rs = 1.f / sqrtf(ss * (1.f / 64.f) + EPS);
#pragma unroll
        for (int ks = 0; ks < 4; ++ks) {
            unsigned wv[4];
#pragma unroll
            for (int jp = 0; jp < 4; ++jp) {
                const int dim = 16 * ks + 8 * h + 2 * jp, pi = dim >> 1;
                const f32x2_t cs = *(const f32x2_t*)(rope + ((size_t)t * 32 + pi) * 2);
                const float xe = x[8 * ks + 2 * jp] * rs * C.in[IN_QNORM][dim], xo = x[8 * ks + 2 * jp + 1] * rs * C.in[IN_QNORM][dim + 1];
                wv[jp] = cvtpk((xe * cs.x - xo * cs.y) * (0.125f * 1.4426950408889634f), (xe * cs.y + xo * cs.x) * (0.125f * 1.4426950408889634f));
            }
            v4u pk; pk.x = wv[0]; pk.y = wv[1]; pk.z = wv[2]; pk.w = wv[3];
            qf[qt][ks] = __builtin_bit_cast(bf16x8, pk);
        }
    }
    f32x16 O00, O01, O10, O11;
#pragma unroll
    for (int i = 0; i < 16; ++i) { O00[i] = 0.f; O01[i] = 0.f; O10[i] = 0.f; O11[i] = 0.f; }
    float mrun0 = -1e30f, mrun1 = -1e30f, lrun0 = 0.f, lrun1 = 0.f;
    const int skey = C.tid >> 2, spart = C.tid & 3;
    v4u rk0, rk1, rv0, rv1;
#define AT_CH(cc_) (((cc_) == 0) ? 1 : ((cc_) == 1 ? 0 : (cc_)))
#define AT_VALID(cc_) (!(AT_CH(cc_) < 3 && (qb - 1 + AT_CH(cc_) < 0 || qb - 1 + AT_CH(cc_) >= 16)))
#define AT_LOAD(cc_) do { const int ch_ = AT_CH(cc_); const bf16* kr_; const bf16* vr_; \
        if (ch_ < 3) { const int pos_ = (qb - 1 + ch_) * 128 + skey; kr_ = Kr + ((size_t)b * L + pos_) * KVW + kvh * 64 + spart * 16; vr_ = V + ((size_t)b * L + pos_) * KVW + kvh * 64 + spart * 16; } \
        else { const int cp_ = (ch_ - 3) * 128 + skey; kr_ = KC + ((size_t)b * LC + cp_) * KVW + kvh * 64 + spart * 16; vr_ = VC + ((size_t)b * LC + cp_) * KVW + kvh * 64 + spart * 16; } \
        rk0 = *(const v4u*)kr_; rk1 = *(const v4u*)(kr_ + 8); rv0 = *(const v4u*)vr_; rv1 = *(const v4u*)(vr_ + 8); } while (0)
    AT_LOAD(0);
    for (int cc = 0; cc < 5; ++cc) {
        const int ch = AT_CH(cc);
        const int kblk = qb - 1 + ch;
        if (!AT_VALID(cc)) continue;
        LDS_BARRIER();
        {
            const int key = skey, part = spart; const int pos = kblk * 128 + key;
            float kf[16];
            const v4u v0 = rv0, v1 = rv1;
            unpack8(rk0, kf); unpack8(rk1, kf + 8);
            float ss = 0.f;
#pragma unroll
            for (int d = 0; d < 16; ++d) ss += kf[d] * kf[d];
            ss += __shfl_xor(ss, 1); ss += __shfl_xor(ss, 2);
            const float rs = 1.f / sqrtf(ss * (1.f / 64.f) + EPS);
            unsigned wv[8];
#pragma unroll
            for (int i = 0; i < 8; ++i) {
                const int pi = part * 8 + i;
                float xe = kf[2 * i] * rs * C.in[IN_KNORM][2 * pi], xo = kf[2 * i + 1] * rs * C.in[IN_KNORM][2 * pi + 1];
                if (ch < 3) { const f32x2_t cs = *(const f32x2_t*)(rope + ((size_t)pos * 32 + pi) * 2); const float a = xe * cs.x - xo * cs.y, bb = xe * cs.y + xo * cs.x; xe = a; xo = bb; }
                wv[i] = cvtpk(xe, xo);
            }
            v4u k0; k0.x = wv[0]; k0.y = wv[1]; k0.z = wv[2]; k0.w = wv[3];
            v4u k1; k1.x = wv[4]; k1.y = wv[5]; k1.z = wv[6]; k1.w = wv[7];
            *(LAS v4u*)(C.lds + AT_KS + key * AT_KROW + part * 32) = k0; *(LAS v4u*)(C.lds + AT_KS + key * AT_KROW + part * 32 + 16) = k1;
            const unsigned vw[8] = {v0.x, v0.y, v0.z, v0.w, v1.x, v1.y, v1.z, v1.w};
#pragma unroll
            for (int j = 0; j < 8; ++j) {
                *(LAS bf16*)(C.lds + AT_VT + (part * 16 + 2 * j) * AT_VROW + key * 2) = (bf16)(vw[j] & 0xffffu);
                *(LAS bf16*)(C.lds + AT_VT + (part * 16 + 2 * j + 1) * AT_VROW + key * 2) = (bf16)(vw[j] >> 16);
            }
        }
        {
            int nc = cc + 1; while (nc < 5 && !AT_VALID(nc)) ++nc;
            if (nc < 5) AT_LOAD(nc);
        }
        LDS_BARRIER();
#pragma unroll 1
        for (int kt = 0; kt < 4; ++kt) {
            const bool sk0 = (ch == 0) ? (2 * qh + 0 > kt) : (ch == 2 ? (kt > 2 * qh + 0) : false);
            const bool sk1 = (ch == 0) ? (2 * qh + 1 > kt) : (ch == 2 ? (kt > 2 * qh + 1) : false);
            if (sk0 && sk1) continue;
            bf16x8 kfr[4];
#pragma unroll
            for (int ks = 0; ks < 4; ++ks) kfr[ks] = *(const LAS bf16x8*)(C.lds + AT_KS + (kt * 32 + q) * AT_KROW + ks * 32 + h * 16);
            bf16x8 vfr[2][2];
#pragma unroll
            for (int dt = 0; dt < 2; ++dt)
#pragma unroll
                for (int sI = 0; sI < 2; ++sI) {
                    const LAS unsigned char* vp = C.lds + AT_VT + (dt * 32 + q) * AT_VROW + (kt * 32 + 16 * sI + 4 * h) * 2;
                    const v2u lo = *(const LAS v2u*)vp, hi2 = *(const LAS v2u*)(vp + 16);
                    v4u pk; pk.x = lo.x; pk.y = lo.y; pk.z = hi2.x; pk.w = hi2.y;
                    vfr[dt][sI] = __builtin_bit_cast(bf16x8, pk);
                }
#pragma unroll
            for (int qt = 0; qt < 2; ++qt) {
                if (qt == 0 ? sk0 : sk1) continue;
                f32x16 sT;
#pragma unroll
                for (int i = 0; i < 16; ++i) sT[i] = 0.f;
#pragma unroll
                for (int ks = 0; ks < 4; ++ks) sT = __builtin_amdgcn_mfma_f32_32x32x16_bf16(kfr[ks], qf[qt][ks], sT, 0, 0, 0);
                if (ch == 0 || ch == 2) {
                    const int tq = qb * 128 + qh * 64 + qt * 32 + q;
#pragma unroll
                    for (int r = 0; r < 16; ++r) { const int sp = kblk * 128 + kt * 32 + (r & 3) + 8 * (r >> 2) + 4 * h; const int df = tq - sp; if (df > 128 || df < -128) sT[r] = -1e30f; }
                }
                float mx = sT[0];
#pragma unroll
                for (int r = 1; r < 16; ++r) mx = fmaxf(mx, sT[r]);
                mx = fmaxf(mx, __shfl_xor(mx, 32));
                const float mo = qt ? mrun1 : mrun0; const float mn = fmaxf(mo, mx), al = __builtin_amdgcn_exp2f(mo - mn);
                float rsum = 0.f; float pv[16];
#pragma unroll
                for (int r = 0; r < 16; ++r) { pv[r] = __builtin_amdgcn_exp2f(sT[r] - mn); rsum += pv[r]; }
                v4u p0, p1;
                p0.x = cvtpk(pv[0], pv[1]); p0.y = cvtpk(pv[2], pv[3]); p0.z = cvtpk(pv[4], pv[5]); p0.w = cvtpk(pv[6], pv[7]);
                p1.x = cvtpk(pv[8], pv[9]); p1.y = cvtpk(pv[10], pv[11]); p1.z = cvtpk(pv[12], pv[13]); p1.w = cvtpk(pv[14], pv[15]);
                const bf16x8 pf0 = __builtin_bit_cast(bf16x8, p0), pf1 = __builtin_bit_cast(bf16x8, p1);
                const bool grew = __any(mn > mo);
                if (qt == 0) {
                    mrun0 = mn; lrun0 = lrun0 * al + rsum;
                    if (grew) {
#pragma unroll
                    for (int i = 0; i < 16; ++i) { O00[i] *= al; O01[i] *= al; } }
                    O00 = __builtin_amdgcn_mfma_f32_32x32x16_bf16(vfr[0][0], pf0, O00, 0, 0, 0); O00 = __builtin_amdgcn_mfma_f32_32x32x16_bf16(vfr[0][1], pf1, O00, 0, 0, 0);
                    O01 = __builtin_amdgcn_mfma_f32_32x32x16_bf16(vfr[1][0], pf0, O01, 0, 0, 0); O01 = __builtin_amdgcn_mfma_f32_32x32x16_bf16(vfr[1][1], pf1, O01, 0, 0, 0);
                } else {
                    mrun1 = mn; lrun1 = lrun1 * al + rsum;
                    if (grew) {
#pragma unroll
                    for (int i = 0; i < 16; ++i) { O10[i] *= al; O11[i] *= al; } }
                    O10 = __builtin_amdgcn_mfma_f32_32x32x16_bf16(vfr[0][0], pf0, O10, 0, 0, 0); O10 = __builtin_amdgcn_mfma_f32_32x32x16_bf16(vfr[0][1], pf1, O10, 0, 0, 0);
                    O11 = __builtin_amdgcn_mfma_f32_32x32x16_bf16(vfr[1][0], pf0, O11, 0, 0, 0); O11 = __builtin_amdgcn_mfma_f32_32x32x16_bf16(vfr[1][1], pf1, O11, 0, 0, 0);
                }
            }
        }
    }
#undef AT_CH
#undef AT_VALID
#undef AT_LOAD
    const float sk = C.in[IN_SINK][hd] * 1.4426950408889634f;
#pragma unroll
    for (int qt = 0; qt < 2; ++qt) {
        const float mo = qt ? mrun1 : mrun0; float l = qt ? lrun1 : lrun0; l += __shfl_xor(l, 32);
        const float mn = fmaxf(mo, sk), al = __builtin_amdgcn_exp2f(mo - mn); l = l * al + __builtin_amdgcn_exp2f(sk - mn);
        const float inv = al / l;
        const int t = qb * 128 + qh * 64 + qt * 32 + q;
        bf16* yr = YB + ((size_t)b * L + t) * QW + hd * 64;
#pragma unroll
        for (int dt = 0; dt < 2; ++dt)
#pragma unroll
            for (int gq = 0; gq < 4; ++gq) {
                float v[4];
#pragma unroll
                for (int i = 0; i < 4; ++i) v[i] = (qt ? (dt ? O11[4 * gq + i] : O10[4 * gq + i]) : (dt ? O01[4 * gq + i] : O00[4 * gq + i])) * inv;
                v2u o; o.x = cvtpk(v[0], v[1]); o.y = cvtpk(v[2], v[3]);
                *(v2u*)(yr + dt * 32 + 8 * gq + 4 * h) = o;
            }
    }
}

__device__ __forceinline__ void p6_phase(const Ctx& C) {
    const int lane = C.lane;
    const float* mod = (const float*)(C.ws + WS_MOD); unsigned char* HX2 = (unsigned char*)(C.ws + WS_HX2); float* AFF = (float*)(C.ws + WS_AFF);
    LAS float* RT = (LAS float*)C.lds;
    LAS float* GM = RT + NE * D;
    LAS float* BB = GM + D;
    const float* XN = (const float*)(C.ws + WS_XNEW);
    __syncthreads();
    for (int i = C.tid; i < D * NE; i += NT) { const int k = i >> 4, e = i & 15; RT[e * D + k] = C.in[IN_ROUTER][i]; }
    for (int blk = C.bid; blk < M / 64; blk += C.nb) {
        const int mb = (blk * 64) >> 11;
        const float* sh = mod + (size_t)mb * MODW + 3 * D; const float* sc = sh + D;
        __syncthreads();
        for (int i = C.tid; i < D; i += NT) { GM[i] = C.in[IN_NORM2][i] * (1.f + sc[i]); BB[i] = sh[i]; }
        __syncthreads();
#pragma unroll 1
        for (int grp = 0; grp < 2; ++grp) {
            const int row0 = blk * 64 + C.wave * 8 + grp * 4;
            const float* xr = XN + (size_t)row0 * D + 4 * lane;
            float rstd[4];
            {
                f32x4 v[4][4];
#pragma unroll
                for (int r = 0; r < 4; ++r)
#pragma unroll
                    for (int j = 0; j < 4; ++j) v[r][j] = *(const f32x4*)(xr + (size_t)r * D + 256 * j);
#pragma unroll
                for (int r = 0; r < 4; ++r) { float s2 = 0.f;
#pragma unroll
                    for (int j = 0; j < 4; ++j) s2 += (v[r][j][0] * v[r][j][0] + v[r][j][1] * v[r][j][1]) + (v[r][j][2] * v[r][j][2] + v[r][j][3] * v[r][j][3]);
                    rstd[r] = 1.f / sqrtf(wave_sum(s2) * (1.f / D) + EPS); }
            }
            float lg[4][16];
#pragma unroll
            for (int r = 0; r < 4; ++r)
#pragma unroll
                for (int e = 0; e < 16; ++e) lg[r][e] = 0.f;
            f32x4 cur[4], nxt[4];
#pragma unroll
            for (int r = 0; r < 4; ++r) cur[r] = *(const f32x4*)(xr + (size_t)r * D);
#pragma unroll 1
            for (int j = 0; j < 4; ++j) {
                const int c0 = 4 * lane + 256 * j; const int jn = (j < 3) ? j + 1 : 3;
#pragma unroll
                for (int r = 0; r < 4; ++r) nxt[r] = *(const f32x4*)(xr + (size_t)r * D + 256 * jn);
                const f32x4 gm = *(const LAS f32x4*)(GM + c0), bb = *(const LAS f32x4*)(BB + c0);
                f32x4 o[4];
#pragma unroll
                for (int r = 0; r < 4; ++r) {
#pragma unroll
                    for (int i = 0; i < 4; ++i) o[r][i] = cur[r][i] * rstd[r] * gm[i] + bb[i];
                    *(unsigned*)(HX2 + (size_t)(row0 + r) * D + c0) = pk4_fp8(o[r][0], o[r][1], o[r][2], o[r][3]);
                }
#pragma unroll
                for (int e = 0; e < 16; ++e) { const f32x4 w = *(const LAS f32x4*)(RT + e * D + c0);
#pragma unroll
                    for (int r = 0; r < 4; ++r) lg[r][e] += (o[r][0] * w[0] + o[r][1] * w[1]) + (o[r][2] * w[2] + o[r][3] * w[3]); }
#pragma unroll
                for (int r = 0; r < 4; ++r) cur[r] = nxt[r];
            }
#pragma unroll
            for (int r = 0; r < 4; ++r) {
                float mx = -1e30f;
#pragma unroll
                for (int e = 0; e < 16; ++e) { lg[r][e] = wave_sum(lg[r][e]); mx = fmaxf(mx, lg[r][e]); }
                float den = 0.f;
#pragma unroll
                for (int e = 0; e < 16; ++e) { lg[r][e] = expf(lg[r][e] - mx); den += lg[r][e]; }
                if (lane < 16) { float val = 0.f;
#pragma unroll
                    for (int e = 0; e < 16; ++e) val = (lane == e) ? lg[r][e] : val;
                    AFF[((size_t)mb * 16 + lane) * L + ((row0 + r) & 2047)] = val / den; }
            }
        }
    }
}

__device__ __forceinline__ void p7_phase(const Ctx& C) {
    const float* AFF = (const float*)(C.ws + WS_AFF); int* SLOT = (int*)(C.ws + WS_SLOT); float* SELG = (float*)(C.ws + WS_SELG);
    const unsigned char* HX2 = (const unsigned char*)(C.ws + WS_HX2); unsigned char* XIN = (unsigned char*)(C.ws + WS_XIN);
    LAS unsigned long long* KY = (LAS unsigned long long*)C.lds;
    LAS int* rk = (LAS int*)(C.lds + 16384);
    ConvSlice kq = conv_slice(C, TR_TK0, 2);
    for (int it = C.bid; it < NB * NE * 2; it += C.nb) {
        const int item = it >> 1, half = it & 1, b = item >> 4, e = item & 15;
        __syncthreads();
        for (int t = C.tid; t < L; t += NT) {
            const unsigned bits = __builtin_bit_cast(unsigned, AFF[((size_t)b * 16 + e) * L + t]);
            KY[t] = ~(((unsigned long long)bits << 32) | (unsigned long long)(2047 - t)); rk[t] = -1;
        }
        __syncthreads();
        TrItem Ta, Tb; f32x4 cva[8], cvb[8]; const bool cv = kq.left >= 2;
        if (cv) { tr_item(C, kq.it, Ta); tr_item(C, kq.it + 1, Tb); tr_load(Ta, C.lane, cva); tr_load(Tb, C.lane, cvb); }
        for (int k = 2; k <= L; k <<= 1)
            for (int j = k >> 1; j > 0; j >>= 1) {
#pragma unroll
                for (int q = 0; q < 2; ++q) {
                    const int pp = C.tid + 512 * q, i = ((pp & ~(j - 1)) << 1) | (pp & (j - 1)), l = i | j;
                    const unsigned long long x = KY[i], y = KY[l]; const bool up = (i & k) == 0;
                    if ((x > y) == up) { KY[i] = y; KY[l] = x; }
                }
                __syncthreads();
            }
        if (cv) { tr_store(Ta, C.lane, cva); tr_store(Tb, C.lane, cvb); kq.it += 2; kq.left -= 2; }
        if (C.tid < CAP) { const unsigned long long key = ~KY[C.tid]; const int t = 2047 - (int)(unsigned)(key & 0xffffffffull); rk[t] = C.tid;
            if (half == 0) SELG[e * 2048 + b * 256 + C.tid] = __builtin_bit_cast(float, (unsigned)(key >> 32)); }
        __syncthreads();
        if (half == 0) for (int t = C.tid; t < L; t += NT) SLOT[((size_t)b * L + t) * 16 + e] = rk[t];
        for (int r0 = half * 128 + C.wave * 16; r0 < half * 128 + C.wave * 16 + 16; r0 += 4) {
            v4u x[4];
#pragma unroll
            for (int k = 0; k < 4; ++k) { const int t = 2047 - (int)(unsigned)((~KY[r0 + k]) & 0xffffffffull); x[k] = *((const v4u*)(HX2 + ((size_t)b * L + t) * D) + C.lane); }
#pragma unroll
            for (int k = 0; k < 4; ++k) *((v4u*)(XIN + ((size_t)e * 2048 + b * 256 + r0 + k) * D) + C.lane) = x[k];
        }
    }
    conv_flush(C, kq);
}

__device__ __forceinline__ void p10_row(const Ctx& C, int row, int sv, unsigned long long mask, const f32x4 (&xin)[4]) {
    const int lane = C.lane, b = row >> 11; const unsigned char* Y = (const unsigned char*)(C.ws + WS_YBUF);
    float* o = C.out + (size_t)row * D + 16 * lane;
    f32x4 acc[4] = {xin[0], xin[1], xin[2], xin[3]};
    while (mask) {
        int ee[4]; float wgt[4];
        const int e0 = __builtin_ctzll(mask);
#pragma unroll
        for (int k = 0; k < 4; ++k) { if (mask) { ee[k] = __builtin_ctzll(mask); mask &= mask - 1; wgt[k] = 1.f / 32.f; } else { ee[k] = e0; wgt[k] = 0.f; } }
        v4u y[4];
#pragma unroll
        for (int k = 0; k < 4; ++k) { const int sl = __builtin_amdgcn_readlane(sv, ee[k]); y[k] = *((const v4u*)(Y + ((size_t)ee[k] * 2048 + b * 256 + sl) * D) + lane); }
#pragma unroll
        for (int k = 0; k < 4; ++k) {
            const unsigned w[4] = {y[k].x, y[k].y, y[k].z, y[k].w};
#pragma unroll
            for (int q = 0; q < 4; ++q) { const f32x2_t lo = __builtin_amdgcn_cvt_pk_f32_fp8((int)w[q], false), hi = __builtin_amdgcn_cvt_pk_f32_fp8((int)w[q], true);
                acc[q][0] += wgt[k] * lo.x; acc[q][1] += wgt[k] * lo.y; acc[q][2] += wgt[k] * hi.x; acc[q][3] += wgt[k] * hi.y; }
        }
    }
#pragma unroll
    for (int q = 0; q < 4; ++q) *(f32x4*)(o + 4 * q) = acc[q];
}
__device__ __forceinline__ void p10_phase(const Ctx& C) {
    const int gw = C.bid * NWAVES + C.wave, NGW = C.nb * NWAVES, lane = C.lane;
    const int* SLOT = (const int*)(C.ws + WS_SLOT); const float* XN = (const float*)(C.ws + WS_XNEW);
    for (int row = gw * 2; row < M; row += NGW * 2) {
        const int sv0 = SLOT[(size_t)row * 16 + (lane & 15)], sv1 = SLOT[(size_t)(row + 1) * 16 + (lane & 15)];
        f32x4 x0[4], x1[4];
        { const float* xi = XN + (size_t)row * D + 16 * lane;
#pragma unroll
          for (int q = 0; q < 4; ++q) { x0[q] = *(const f32x4*)(xi + 4 * q); x1[q] = *(const f32x4*)(xi + D + 4 * q); } }
        const unsigned long long m0 = __ballot(sv0 >= 0) & 0xffffull, m1 = __ballot(sv1 >= 0) & 0xffffull;
        p10_row(C, row, sv0, m0, x0); p10_row(C, row + 1, sv1, m1, x1);
    }
}

__global__ void __launch_bounds__(NT, 2) mk_fwd(Args args) {
    extern __shared__ __attribute__((aligned(16))) unsigned char lds_raw[];
    Ctx C;
    C.lds = (LAS unsigned char*)lds_raw; C.tid = threadIdx.x; C.lane = C.tid & 63; C.wave = __builtin_amdgcn_readfirstlane(C.tid >> 6);
    C.bid = blockIdx.x; C.nb = gridDim.x; C.out = args.out; C.ws = args.ws; C.sub = args.sub;
#pragma unroll
    for (int i = 0; i < 30; ++i) C.in[i] = args.in[i];
    volatile LAS unsigned* MISC = (volatile LAS unsigned*)(C.lds + MISC_OFF);
    if (C.tid < 32) MISC[C.tid] = 0u;
    __syncthreads();
    unsigned* ctl = (unsigned*)(C.ws + WS_CTL);
    XcdBarrier bar; bar.bar = ctl + CW_BAR + args.li * XCD_BAR_WORDS; bar.x = 0; bar.st = nullptr;
    if (N_LAUNCHES != NPH) bar = xcd_barrier_post(ctl + CW_BAR + args.li * XCD_BAR_WORDS, MISC + 8);
    const int lo = args.ph_lo, hi = args.ph_hi;
#ifndef PH_MASK
#define PH_MASK 0xfff
#endif
#define IN(k) (((PH_MASK >> (k)) & 1) && lo <= (k) && (k) < hi)
#define SEAM(k) do { if (IN(k) && IN((k) + 1)) xcd_barrier(bar); } while (0)
    unsigned char* ws = C.ws;
    if (IN(0)) { p0_phase(C); } if (C.nb != 256) SEAM(0);
    if (IN(1)) { p1_phase(C); } SEAM(1);
    if (IN(2)) {
        pg8::SchedIn S{(const char*)(ws + WS_HX), (const char*)(ws + WS_WINT), C.nb, C.bid};
        pg8::Epi<EpiP2> E{{EpiZ{(bf16*)(ws + WS_ZT)}, EpiIn{(bf16*)(ws + WS_QRAW), (bf16*)(ws + WS_KRAW), (bf16*)(ws + WS_VB), (bf16*)(ws + WS_KC), (bf16*)(ws + WS_VC), (unsigned char*)(ws + WS_GA), (unsigned char*)(ws + WS_GB)}}};
        pg8::gemm_phase(C.lds, D, S, E);
        { pg8::SchedGate S8{(const char*)(ws + WS_HX8), (const char*)(ws + WS_WG8), C.nb, C.bid};
          pg8::gemm_phase<pg8::Epi<EpiP2>, pg8::SchedGate, true>(C.lds, D / 2, S8, E); }
        if (C.nb == 256 && C.bid >= 144) {
            TrItem Ta, Tb; f32x4 va[8], vb[8]; const int w0 = TR_NITEMS - TR_TAIL + ((C.bid - 144) * NWAVES + C.wave) * 8;
#pragma unroll 1
            for (int r = 0; r < 4; ++r) { tr_item(C, w0 + 2 * r, Ta); tr_item(C, w0 + 2 * r + 1, Tb); tr_load(Ta, C.lane, va); tr_load(Tb, C.lane, vb); tr_store(Ta, C.lane, va); tr_store(Tb, C.lane, vb); }
        }
    } SEAM(2);
    if (IN(3)) {
        if (C.nb == 256) { tap_table(C); asm volatile("s_waitcnt vmcnt(0)" ::: "memory"); __syncthreads(); }
        const bool attn_first = ((C.bid >> 3) & 1) != 0;
        if (attn_first) {
            if ((args.sub & 3) != 1) for (int it = C.bid; it < NB * 2 * 16; it += C.nb) attn_fast(C, it);
            __syncthreads();
            ConvSlice cq = conv_slice(C, TR_HY0, 16);
            if ((args.sub & 3) != 2) { hyena_zero_pads(C);
                for (int c = C.bid; c < HW; c += C.nb) hyena_fast(C, c, (c + C.nb < HW) ? c + C.nb : -1, cq); }
            conv_flush(C, cq);
        } else {
            ConvSlice cq = conv_slice(C, TR_HY0, 16);
            if ((args.sub & 3) != 2) { hyena_zero_pads(C);
                for (int c = C.bid; c < HW; c += C.nb) hyena_fast(C, c, (c + C.nb < HW) ? c + C.nb : -1, cq); }
            conv_flush(C, cq);
            __syncthreads();
            if ((args.sub & 3) != 1) for (int it = C.bid; it < NB * 2 * 16; it += C.nb) attn_fast(C, it);
        }
    } SEAM(3);
    if (IN(4)) { ya_transpose(C); } SEAM(4);
    if (IN(5)) {
        pg8::SchedP5 S{(const char*)(ws + WS_YA), (const char*)(ws + WS_WAT), (const char*)(ws + WS_YB), (const char*)(ws + WS_WBT), C.nb, C.bid};
        pg8::Epi<EpiP5> E{{EpiT1{(const unsigned char*)(ws + WS_GA), (bf16*)(ws + WS_TA)}, EpiT2{(const unsigned char*)(ws + WS_GB), (const bf16*)(ws + WS_TA), (bf16*)(ws + WS_MM)}}};
        pg8::gemm_phase(C.lds, HW, S, E);
    } SEAM(5);
    if (IN(6)) {
        pg8::SchedStd S{(const char*)(ws + WS_MM), (const char*)(ws + WS_WOUTT), D, 64, 4, C.nb, C.bid, 0};
        pg8::Epi<K0<EpiOut>> E{{EpiOut{C.in[IN_X], (const float*)(ws + WS_MOD), (float*)(ws + WS_XNEW)}}};
        pg8::gemm_phase(C.lds, D, S, E);
    } SEAM(6);
    if (IN(7)) { p6_phase(C); } SEAM(7);
    if (IN(8)) { p7_phase(C); } SEAM(8);
    if (IN(9)) {
        pg8::SchedStd S{(const char*)(ws + WS_XIN), (const char*)(ws + WS_W1T), D / 2, 128, 16, C.nb, C.bid, (size_t)4096 * D};
        pg8::Epi<K0<EpiH>> E{{EpiH{(unsigned char*)(ws + WS_HB)}}};
        pg8::gemm_phase<pg8::Epi<K0<EpiH>>, pg8::SchedStd, true>(C.lds, D / 2, S, E);
    } SEAM(9);
    if (IN(10)) {
        pg8::SchedStd S{(const char*)(ws + WS_HB), (const char*)(ws + WS_W2T), DFF / 2, 128, 4, C.nb, C.bid, (size_t)1024 * DFF};
        pg8::Epi<K0<EpiY>> E{{EpiY{(const float*)(ws + WS_SELG), (const float*)(ws + WS_MOD), (unsigned char*)(ws + WS_YBUF)}}};
        pg8::gemm_phase<pg8::Epi<K0<EpiY>>, pg8::SchedStd, true>(C.lds, DFF / 2, S, E);
    } SEAM(10);
    if (IN(11)) { p10_phase(C); }
#undef IN
#undef SEAM
}

extern "C" void kernel_launch(void* const* d_in, const int* in_sizes, int n_in, void* d_out, int out_size, void* d_ws, size_t ws_size, hipStream_t stream) {
    static int grid = 0;
    if (grid == 0) {
        if (n_in != 30 || in_sizes[0] != M * D || out_size != M * D || ws_size < WS_END) { fprintf(stderr, "kernel_launch: unexpected shapes: n_in %d in0 %d out %d ws %zu (need %zu)\n", n_in, n_in > 0 ? in_sizes[0] : -1, out_size, ws_size, (size_t)WS_END); grid = -1; return; }
        int dev = 0, cus = 0, per_cu = 0;
        if (hipGetDevice(&dev) != hipSuccess || hipDeviceGetAttribute(&cus, hipDeviceAttributeMultiprocessorCount, dev) != hipSuccess) { grid = -1; return; }
        if (hipFuncSetAttribute((const void*)mk_fwd, hipFuncAttributeMaxDynamicSharedMemorySize, LDS_BYTES) != hipSuccess) { fprintf(stderr, "kernel_launch: hipFuncSetAttribute failed\n"); grid = -1; return; }
        if (hipOccupancyMaxActiveBlocksPerMultiprocessor(&per_cu, (const void*)mk_fwd, NT, LDS_BYTES) != hipSuccess || per_cu < 1) { fprintf(stderr, "kernel_launch: occupancy query says %d\n", per_cu); per_cu = 1; }
        (void)hipGetLastError();
        grid = cus;
    }
    if (grid < 0) return;
    if (hipMemsetAsync((char*)d_ws + WS_CTL, 0, CTL_ZERO_BYTES, stream) != hipSuccess) { fprintf(stderr, "kernel_launch: memset failed\n"); return; }
    Args a{};
    for (int i = 0; i < 30; ++i) a.in[i] = (const float*)d_in[i];
    a.out = (float*)d_out; a.ws = (unsigned char*)d_ws;
    if (N_LAUNCHES == NPH) {
        for (int li = 0; li < NPH; ++li) { a.ph_lo = li; a.ph_hi = li + 1; a.li = 0;
            for (int rep = 0; rep < (((DUP_MASK >> li) & 1) ? 2 : 1); ++rep) { a.sub = (rep == 0 && ((DUP_MASK >> li) & 1)) ? DUP_SUB : 0; hipLaunchKernelGGL(mk_fwd, dim3(grid), dim3(NT), LDS_BYTES, stream, a); } }
    } else {
        a.ph_lo = 0; a.ph_hi = NPH; a.li = 0;
        hipLaunchKernelGGL(mk_fwd, dim3(grid), dim3(NT), LDS_BYTES, stream, a);
    }
}
```

```cpp
#include <hip/hip_runtime.h>
#include <cstdio>
#include <cstdint>

#define GAS __attribute__((address_space(1)))
#define LAS __attribute__((address_space(3)))
typedef unsigned short bf16;
typedef unsigned v4u __attribute__((ext_vector_type(4)));
typedef unsigned v2u __attribute__((ext_vector_type(2)));
typedef float f32x4 __attribute__((ext_vector_type(4)));
typedef short bf16x8 __attribute__((ext_vector_type(8)));

#ifndef DUP_MASK
#define DUP_MASK 0
#endif
#ifndef DUP_SUB
#define DUP_SUB 0
#endif
#ifndef MK_N_LAUNCHES
#define MK_N_LAUNCHES 1
#endif
constexpr int NPH = 12;
constexpr int N_LAUNCHES = MK_N_LAUNCHES;
constexpr int NWAVES = 8, NT = NWAVES * 64;

constexpr int D = 1024, NB = 8, L = 2048, LC = 256, M = NB * L, MC = NB * LC, MT = M + MC;
constexpr int HW = 512, QW = 512, KVW = 128, NE = 16, CAP = 256, DFF = 2048, INW = 4352;
constexpr int OFF_Q = 1536, OFF_K = 2048, OFF_V = 2176, OFF_G = 2304;
constexpr int MODW = 6 * D;
constexpr float EPS = 1e-6f;
constexpr int GT_LEN = 4096;

constexpr size_t MiB = 1u << 20;
constexpr size_t WS_CTL = 0, CTL_ZERO_BYTES = 64 * 1024;
constexpr size_t WS_MOD = 1 * MiB;
constexpr size_t WS_H3 = 1 * MiB + 512 * 1024;
constexpr size_t WS_ROPE = 2 * MiB;
constexpr size_t WS_AFF = 3 * MiB;
constexpr size_t WS_SLOT = 4 * MiB;
constexpr size_t WS_SELG = 5 * MiB;
constexpr size_t WS_GTAB = 6 * MiB;
constexpr size_t WS_WINT = 14 * MiB;
constexpr size_t WS_WAT = 23 * MiB;
constexpr size_t WS_WBT = 24 * MiB;
constexpr size_t WS_WOUTT = 25 * MiB;
constexpr size_t WS_W1T = 28 * MiB;
constexpr size_t WS_HX8 = 92 * MiB;
constexpr size_t WS_WG8 = 108 * MiB;
constexpr size_t WS_W2T = 156 * MiB;
constexpr size_t WS_R1 = 220 * MiB;
constexpr size_t WS_HX = WS_R1;
constexpr size_t WS_ZT = WS_R1 + 36 * MiB;
constexpr size_t WS_QRAW = WS_R1 + 84 * MiB;
constexpr size_t WS_KRAW = WS_R1 + 100 * MiB;
constexpr size_t WS_VB = WS_R1 + 104 * MiB;
constexpr size_t WS_KC = WS_R1 + 108 * MiB;
constexpr size_t WS_VC = WS_R1 + 108 * MiB + 512 * 1024;
constexpr size_t WS_YAT = WS_R1 + 110 * MiB;
constexpr size_t WS_TA = WS_R1;
constexpr size_t WS_MM = WS_R1 + 32 * MiB;
constexpr size_t WS_HB = WS_R1;
constexpr size_t WS_R2 = 348 * MiB;
constexpr size_t WS_GA = WS_R2, WS_GB = WS_R2 + 32 * MiB;
constexpr size_t WS_XIN = WS_R2;
constexpr size_t WS_YBUF = WS_R2;
constexpr size_t WS_R3 = 412 * MiB;
constexpr size_t WS_YA = WS_R3, WS_YB = WS_R3 + 16 * MiB;
constexpr size_t WS_HX2 = WS_R3;
constexpr size_t WS_XNEW = 444 * MiB;
constexpr size_t WS_END = 508 * MiB;

constexpr int CW_BAR = 4096;
constexpr int LDS_BYTES = 147456;
constexpr int MISC_OFF = 147456 - 256;

__device__ __forceinline__ unsigned f2bf(float f) { unsigned u = __builtin_bit_cast(unsigned, f); return (u + 0x7fffu + ((u >> 16) & 1u)) >> 16; }
typedef float f32x2_t __attribute__((ext_vector_type(2)));
typedef __bf16 bf16x2_t __attribute__((ext_vector_type(2)));
__device__ __forceinline__ unsigned cvtpk(float lo, float hi) { f32x2_t v = {lo, hi}; bf16x2_t b = __builtin_convertvector(v, bf16x2_t); return __builtin_bit_cast(unsigned, b); }
__device__ __forceinline__ unsigned pk2(float lo, float hi) { return cvtpk(lo, hi); }
__device__ __forceinline__ unsigned pk4_fp8(float a, float b, float c, float d) { int w = 0; w = __builtin_amdgcn_cvt_pk_fp8_f32(a, b, w, false); w = __builtin_amdgcn_cvt_pk_fp8_f32(c, d, w, true); return (unsigned)w; }
__device__ __forceinline__ float bf2f(unsigned b) { return __builtin_bit_cast(float, b << 16); }
__device__ __forceinline__ float bflo(unsigned w) { return __builtin_bit_cast(float, w << 16); }
__device__ __forceinline__ float bfhi(unsigned w) { return __builtin_bit_cast(float, w & 0xffff0000u); }
__device__ __forceinline__ float rbf(float f) { return bf2f(f2bf(f)); }
__device__ __forceinline__ void unpack8_u8(v2u w, float* o) {
    const float k = 1.f / 255.f;
    o[0] = (float)(w.x & 255u) * k; o[1] = (float)((w.x >> 8) & 255u) * k; o[2] = (float)((w.x >> 16) & 255u) * k; o[3] = (float)(w.x >> 24) * k;
    o[4] = (float)(w.y & 255u) * k; o[5] = (float)((w.y >> 8) & 255u) * k; o[6] = (float)((w.y >> 16) & 255u) * k; o[7] = (float)(w.y >> 24) * k; }
__device__ __forceinline__ void unpack8(v4u w, float* o) { o[0] = bflo(w.x); o[1] = bfhi(w.x); o[2] = bflo(w.y); o[3] = bfhi(w.y); o[4] = bflo(w.z); o[5] = bfhi(w.z); o[6] = bflo(w.w); o[7] = bfhi(w.w); }
__device__ __forceinline__ v4u pack8(const float* v) { v4u w; w.x = pk2(v[0], v[1]); w.y = pk2(v[2], v[3]); w.z = pk2(v[4], v[5]); w.w = pk2(v[6], v[7]); return w; }
__device__ __forceinline__ float siluf(float x) { return x * __builtin_amdgcn_rcpf(1.f + __expf(-x)); }
__device__ __forceinline__ float sigmf(float x) { return __builtin_amdgcn_rcpf(1.f + __expf(-x)); }
__device__ __forceinline__ float wave_sum(float v) {
#pragma unroll
    for (int o = 1; o < 64; o <<= 1) v += __shfl_xor(v, o);
    return v;
}
#define LDS_WAIT() asm volatile("s_waitcnt lgkmcnt(0)" ::: "memory")
#define LDS_BARRIER() do { asm volatile("s_waitcnt lgkmcnt(0)" ::: "memory"); __builtin_amdgcn_s_barrier(); asm volatile("" ::: "memory"); } while (0)

#define XB_TMO      128
#define XB_XCNT(j)  (256  + 64 * (j))
#define XB_XSUB(j)  (1280 + 64 * (j))
#define XB_XGEN(j)  (2304 + 64 * (j))
#define XB_TOP      3328
#define XB_TOPGEN   3392
#define XCD_BAR_WORDS 3456
#define XB_SPIN_CAP (1u << 25)
__device__ __forceinline__ unsigned xb_ld(unsigned* p)              { return __hip_atomic_load(p, __ATOMIC_RELAXED, __HIP_MEMORY_SCOPE_AGENT); }
__device__ __forceinline__ unsigned xb_add(unsigned* p, unsigned v) { return __hip_atomic_fetch_add(p, v, __ATOMIC_RELAXED, __HIP_MEMORY_SCOPE_AGENT); }
__device__ __forceinline__ unsigned xb_xcc_id() { return (unsigned)__builtin_amdgcn_s_getreg((3 << 11) | 20) & 0xFu; }
#define XB_SPIN(cond, bar) do { unsigned _sp = 0; while (cond) { __builtin_amdgcn_s_sleep(1); \
    if ((++_sp & 255u) == 0u) { if (xb_ld(&(bar)[XB_TMO])) break; if (_sp > XB_SPIN_CAP) { atomicAdd(&(bar)[XB_TMO], 1u); break; } } } } while (0)
struct XcdBarrier { unsigned* bar; unsigned x; volatile LAS unsigned* st; };
__device__ __forceinline__ XcdBarrier xcd_barrier_post(unsigned* bar, volatile LAS unsigned* st) {
    XcdBarrier b; b.bar = bar; b.x = xb_xcc_id(); b.st = st;
    if (threadIdx.x == 0) (void)xb_add(&bar[XB_XCNT(b.x)], 1u);
    return b;
}
__device__ __forceinline__ void xcd_barrier_complete(unsigned* bar, unsigned x, unsigned& nloc, unsigned& nx) {
    const unsigned G = gridDim.x * gridDim.y * gridDim.z;
    unsigned sum, cnt, mine, sp = 0u;
    for (;;) {
        sum = 0u; cnt = 0u; mine = 0u;
#pragma unroll
        for (unsigned j = 0; j < 16; ++j) { const unsigned c = xb_ld(&bar[XB_XCNT(j)]); sum += c; cnt += (c > 0u) ? 1u : 0u; mine = (j == x) ? c : mine; }
        if (sum == G) break;
        __builtin_amdgcn_s_sleep(1);
        if ((++sp & 255u) == 0u) { if (xb_ld(&bar[XB_TMO])) break; if (sp > XB_SPIN_CAP) { atomicAdd(&bar[XB_TMO], 1u); break; } }
    }
    nloc = mine > 0u ? mine : 1u; nx = cnt > 0u ? cnt : 1u;
}
__device__ __forceinline__ void xcd_barrier(const XcdBarrier& b) {
    asm volatile("s_waitcnt vmcnt(0)" ::: "memory");
    __syncthreads();
    if (threadIdx.x == 0) {
        unsigned* bar = b.bar;
        __builtin_amdgcn_s_waitcnt(0);
        unsigned nloc = b.st[0], nx = b.st[1];
        if (nloc == 0u) { xcd_barrier_complete(bar, b.x, nloc, nx); b.st[0] = nloc; b.st[1] = nx; }
        const unsigned old = xb_add(&bar[XB_XSUB(b.x)], 1u);
        const unsigned gen = old / nloc;
        if (old + 1u == (gen + 1u) * nloc) {
            __builtin_amdgcn_fence(__ATOMIC_RELEASE, "agent");
            asm volatile("s_waitcnt vmcnt(0)" ::: "memory");
            const unsigned og = xb_add(&bar[XB_TOP], 1u);
            const unsigned tg = og / nx;
            if (og + 1u == (tg + 1u) * nx) xb_add(&bar[XB_TOPGEN], 1u);
            else XB_SPIN(xb_ld(&bar[XB_TOPGEN]) == tg, bar);
            __builtin_amdgcn_fence(__ATOMIC_ACQUIRE, "agent");
            xb_add(&bar[XB_XGEN(b.x)], 1u);
            asm volatile("s_waitcnt vmcnt(0)" ::: "memory");
        } else {
            XB_SPIN(xb_ld(&bar[XB_XGEN(b.x)]) == gen, bar);
            __builtin_amdgcn_fence(__ATOMIC_ACQUIRE, "agent");
            asm volatile("s_waitcnt vmcnt(0)" ::: "memory");
        }
    }
    __syncthreads();
}

constexpr int CW_SB0 = 2048;
__device__ __forceinline__ void sb_arrive(unsigned* cnt) {
    asm volatile("s_waitcnt vmcnt(0)" ::: "memory");
    __syncthreads();
    if (threadIdx.x == 0) { __builtin_amdgcn_fence(__ATOMIC_RELEASE, "agent"); asm volatile("s_waitcnt vmcnt(0)" ::: "memory"); (void)xb_add(cnt, 1u); }
}
__device__ __forceinline__ void sb_wait(unsigned* cnt, unsigned target, unsigned* tmo) {
    if (threadIdx.x == 0) {
        unsigned sp = 0u;
        while (xb_ld(cnt) < target) { __builtin_amdgcn_s_sleep(1); if ((++sp & 255u) == 0u) { if (xb_ld(tmo)) break; if (sp > XB_SPIN_CAP) { atomicAdd(tmo, 1u); break; } } }
        __builtin_amdgcn_fence(__ATOMIC_ACQUIRE, "agent"); asm volatile("s_waitcnt vmcnt(0)" ::: "memory");
    }
    __syncthreads();
}

struct Args { const float* in[30]; float* out; unsigned char* ws; int ph_lo, ph_hi, li, sub; };
struct Ctx {
    LAS unsigned char* lds; int tid, lane, wave, bid, nb, sub;
    const float* in[30]; float* out; unsigned char* ws;
};
#define IN_X 0
#define IN_C 1
#define IN_CTX 2
#define IN_CCTX 3
#define IN_ADAW 4
#define IN_ADAB 5
#define IN_NORM1 6
#define IN_NORM2 7
#define IN_WIN 8
#define IN_CONVW 9
#define IN_CONVB 10
#define IN_FW1 11
#define IN_FB1 12
#define IN_FW2 13
#define IN_FB2 14
#define IN_FW3 15
#define IN_FB3 16
#define IN_FFREQ 17
#define IN_FOUT 18
#define IN_HBIAS 19
#define IN_QNORM 20
#define IN_KNORM 21
#define IN_SINK 22
#define IN_WA 23
#define IN_WB 24
#define IN_WOUT 25
#define IN_ROUTER 26
#define IN_WGATE 27
#define IN_WUP 28
#define IN_WDOWN 29

template <class Epi, class Units>
__device__ __forceinline__ void gemm_naive(const Ctx& C, int K, int lda, int ldb, const Units& U, const Epi& E) {
    LAS float* As = (LAS float*)C.lds;
    LAS float* Bs = As + 32 * 132;
    const int tid = C.tid, ty = tid >> 4, tx = tid & 15;
    for (int idx = C.bid;; idx += C.nb) {
        int pm, pn; const bf16* Ab; const bf16* Bb;
        if (!U.get(idx, pm, pn, Ab, Bb)) break;
        for (int half = 0; half < 2; ++half) {
            float acc[4][16];
#pragma unroll
            for (int r = 0; r < 4; ++r)
#pragma unroll
                for (int j = 0; j < 16; ++j) acc[r][j] = 0.f;
            for (int k0 = 0; k0 < K; k0 += 32) {
                {
                    const int row = tid >> 2, kc = tid & 3;
                    const v4u w = *(const v4u*)(Ab + (size_t)(half * 128 + row) * lda + k0 + kc * 8);
                    float f[8]; unpack8(w, f);
#pragma unroll
                    for (int j = 0; j < 8; ++j) As[(kc * 8 + j) * 132 + row] = f[j];
                }
#pragma unroll
                for (int i = 0; i < 2; ++i) {
                    const int c = tid + 512 * i, row = c >> 2, kc = c & 3;
                    const v4u w = *(const v4u*)(Bb + (size_t)row * ldb + k0 + kc * 8);
                    float f[8]; unpack8(w, f);
#pragma unroll
                    for (int j = 0; j < 8; ++j) Bs[(kc * 8 + j) * 260 + row] = f[j];
                }
                __syncthreads();
#pragma unroll 4
                for (int k = 0; k < 32; ++k) {
                    const f32x4 a = *(const LAS f32x4*)(As + k * 132 + ty * 4);
                    const f32x4 b0 = *(const LAS f32x4*)(Bs + k * 260 + tx * 8), b1 = *(const LAS f32x4*)(Bs + k * 260 + tx * 8 + 4);
                    const f32x4 b2 = *(const LAS f32x4*)(Bs + k * 260 + 128 + tx * 8), b3 = *(const LAS f32x4*)(Bs + k * 260 + 128 + tx * 8 + 4);
#pragma unroll
                    for (int r = 0; r < 4; ++r) {
#pragma unroll
                        for (int j = 0; j < 4; ++j) { acc[r][j] += a[r] * b0[j]; acc[r][4 + j] += a[r] * b1[j]; acc[r][8 + j] += a[r] * b2[j]; acc[r][12 + j] += a[r] * b3[j]; }
                    }
                }
                __syncthreads();
            }
#pragma unroll
            for (int r = 0; r < 4; ++r) E(pm * 256 + half * 128 + ty * 4 + r, pn, tx * 8, &acc[r][0], &acc[r][8]);
        }
    }
}


namespace pg8 {
constexpr int BM = 256, BK = 64, HALF = 128, HTB = HALF * BK * 2, NXCD = 8, WGM = 8;
__device__ __forceinline__ int lds_byte(int r, int c) { const int st = (r >> 4) * 2 + (c >> 5), rr = r & 15, cc = c & 31, ob = rr * 64 + cc * 2; return st * 1024 + (ob ^ (((ob >> 9) & 1) << 5)); }
__device__ __forceinline__ void stage_rc(int b, int& R, int& C) { const int st = b / 1024, sb = b % 1024, swz = sb ^ (((sb >> 9) & 1) << 5); R = (st >> 1) * 16 + swz / 64; C = (st & 1) * 32 + (swz % 64) / 2; }
__device__ __forceinline__ int perm32(int rho) { const int n = rho >> 4, i = rho & 15; return 8 * (i >> 2) + 4 * n + (i & 3); }
struct Unit { int pm, pn, kind; const char* A; const char* B; };
__device__ __forceinline__ void tile_of(int w, int nM, int nN, int& pm, int& pn) {
    const int nwg = nM * nN; int wgid = w; { const int q = nwg / NXCD, r = nwg % NXCD, xcd = wgid % NXCD, off = wgid / NXCD; wgid = (xcd < r ? xcd * (q + 1) : r * (q + 1) + (xcd - r) * q) + off; }
    const int nig = WGM * nN, gid = wgid / nig, fm = gid * WGM, gsz = (nM - fm) < WGM ? (nM - fm) : WGM;
    pm = fm + ((wgid % nig) % gsz); pn = (wgid % nig) / gsz;
}
template <class F> struct Epi {
    F f;
    __device__ __forceinline__ void operator()(const f32x4 (&acc)[2][2][4][2], const Unit& u, int wr, int wc, int fr, int fq) const {
#pragma unroll
        for (int ai = 0; ai < 2; ++ai)
#pragma unroll
            for (int m = 0; m < 4; ++m) {
                float v0[8], v1[8];
#pragma unroll
                for (int n = 0; n < 2; ++n)
#pragma unroll
                    for (int i = 0; i < 4; ++i) { v0[4 * n + i] = acc[ai][0][m][n][i]; v1[4 * n + i] = acc[ai][1][m][n][i]; }
                f(u.kind, u.pm * BM + ai * HALF + wr * 64 + m * 16 + fr, u.pn, wc * 32 + 8 * fq, v0, v1);
            }
    }
};
template <class EpiT, class Sched, bool FP8 = false>
__device__ __forceinline__ void gemm_phase(LAS unsigned char* lds, const int K, const Sched& S, const EpiT& E) {
    const int tid = threadIdx.x, wid = __builtin_amdgcn_readfirstlane(tid >> 6), lane = tid & 63, wr = wid >> 2, wc = wid & 3, fr = lane & 15, fq = lane >> 4;
    const int nt = K / BK;
    unsigned voffA[2], voffB[2];
#pragma unroll
    for (int i = 0; i < 2; ++i) { int R, C; stage_rc(tid * 16 + i * 8192, R, C); const int Rb = (R & ~31) + perm32(R & 31);
        voffA[i] = (unsigned)(R * K + C) * 2u; voffB[i] = (unsigned)(Rb * K + C) * 2u; }
    const size_t kstep = (size_t)(BK * 2);
    const size_t hstep = (size_t)HALF * K * 2;
    const unsigned ldsw = (unsigned)wid * 1024u;
    const int aoff = lds_byte(wr * 64 + fr, fq * 8), boff = lds_byte(wc * 32 + fr, fq * 8);
#define PG8_SA(b, h) (((b) * 2 + (h)) * HTB)
#define PG8_SB(b, h) ((4 + (b) * 2 + (h)) * HTB)
#define PG8_STAGE(bufoff, gbase, voff) do { _Pragma("unroll") for (int _i = 0; _i < 2; ++_i) \
        __builtin_amdgcn_global_load_lds((const unsigned*)((const char*)(gbase) + (voff)[_i]), (LAS unsigned*)(lds + (bufoff) + ldsw + _i * 8192), 16, 0, 0); } while (0)
#define PG8_LDA(dst, b, h) do { _Pragma("unroll") for (int m = 0; m < 4; ++m) { if constexpr (FP8) { \
        dst##8[m] = __builtin_shufflevector(*(const LAS v4i_*)(lds + PG8_SA(b, h) + aoff + m * 2048), *(const LAS v4i_*)(lds + PG8_SA(b, h) + aoff + m * 2048 + 1024), 0, 1, 2, 3, 4, 5, 6, 7); } \
        else { _Pragma("unroll") for (int k = 0; k < 2; ++k) dst[m][k] = *(const LAS bf16x8*)(lds + PG8_SA(b, h) + aoff + m * 2048 + k * 1024); } } } while (0)
#define PG8_LDB(dst, b, h) do { _Pragma("unroll") for (int n = 0; n < 2; ++n) { if constexpr (FP8) { \
        dst##8[n] = __builtin_shufflevector(*(const LAS v4i_*)(lds + PG8_SB(b, h) + boff + n * 2048), *(const LAS v4i_*)(lds + PG8_SB(b, h) + boff + n * 2048 + 1024), 0, 1, 2, 3, 4, 5, 6, 7); } \
        else { _Pragma("unroll") for (int k = 0; k < 2; ++k) dst[n][k] = *(const LAS bf16x8*)(lds + PG8_SB(b, h) + boff + n * 2048 + k * 1024); } } } while (0)
#define PG8_MMA(ai, bj, At, Bt) do { __builtin_amdgcn_s_setprio(1); _Pragma("unroll") for (int m = 0; m < 4; ++m) _Pragma("unroll") for (int n = 0; n < 2; ++n) { \
        if constexpr (FP8) asm volatile("v_mfma_scale_f32_16x16x128_f8f6f4 %0, %1, %2, %0, %3, %4 op_sel_hi:[0,0,0]" : "+v"(acc[ai][bj][m][n]) : "v"(Bt##8[n]), "v"(At##8[m]), "v"(sc_w), "v"(sc_x)); \
        else { _Pragma("unroll") for (int k = 0; k < 2; ++k) acc[ai][bj][m][n] = __builtin_amdgcn_mfma_f32_16x16x32_bf16(Bt[n][k], At[m][k], acc[ai][bj][m][n], 0, 0, 0); } } \
        __builtin_amdgcn_s_setprio(0); } while (0)
#define PG8_WAIT_V(n) asm volatile("s_waitcnt vmcnt(" #n ")" ::: "memory")
#define PG8_WAIT_L(n) asm volatile("s_waitcnt lgkmcnt(" #n ")" ::: "memory")
#define PG8_BAR __builtin_amdgcn_s_barrier()
#define PG8_SCHED __builtin_amdgcn_sched_barrier(0)
    Unit cur, nxt; int ui = 0;
    if (!S.next(0, cur)) return;
    f32x4 acc[2][2][4][2];
#pragma unroll
    for (int a = 0; a < 2; ++a)
#pragma unroll
        for (int b = 0; b < 2; ++b)
#pragma unroll
            for (int m = 0; m < 4; ++m)
#pragma unroll
                for (int n = 0; n < 2; ++n) acc[a][b][m][n] = (f32x4){0.f, 0.f, 0.f, 0.f};
    typedef int v4i_ __attribute__((ext_vector_type(4))); typedef int v8i_ __attribute__((ext_vector_type(8)));
    const int sc_w = 0x7a7a7a7a, sc_x = 0x7f7f7f7f;
    bf16x8 At[4][2], B0[2][2], B1[2][2]; v8i_ At8[4], B08[2], B18[2];
    const char* cA = cur.A; const char* cB = cur.B;
    PG8_STAGE(PG8_SB(0, 0), cB, voffB); PG8_STAGE(PG8_SB(0, 1), cB + hstep, voffB); PG8_STAGE(PG8_SA(0, 0), cA, voffA); PG8_STAGE(PG8_SA(0, 1), cA + hstep, voffA);
    if (wr == 1) PG8_BAR;
    PG8_WAIT_V(2); PG8_BAR;
    PG8_STAGE(PG8_SB(1, 0), cB + kstep, voffB); PG8_STAGE(PG8_SA(1, 0), cA + kstep, voffA); PG8_STAGE(PG8_SB(1, 1), cB + hstep + kstep, voffB);
    PG8_WAIT_V(6); PG8_BAR;
    for (;;) {
        const bool has_next = S.next(ui + 1, nxt);
        const char* nA = has_next ? nxt.A : cA; const char* nB = has_next ? nxt.B : cB;
        for (int t = 0; t < nt; t += 2) {
            const bool last = (t == nt - 2);
            const char* a1 = cA + (size_t)(t + 1) * kstep;
            const char* a2 = last ? nA : cA + (size_t)(t + 2) * kstep; const char* b2 = last ? nB : cB + (size_t)(t + 2) * kstep;
            const char* a3 = a2 + kstep; const char* b3 = b2 + kstep;
            PG8_LDB(B0, 0, 0); PG8_LDB(B1, 0, 1); PG8_SCHED; PG8_LDA(At, 0, 0); PG8_STAGE(PG8_SA(1, 1), a1 + hstep, voffA);
            PG8_WAIT_V(8); PG8_WAIT_L(0); PG8_BAR; PG8_MMA(0, 0, At, B0); PG8_MMA(0, 1, At, B1); PG8_BAR; PG8_SCHED;
            PG8_LDA(At, 0, 1); PG8_STAGE(PG8_SB(0, 0), b2, voffB); PG8_STAGE(PG8_SB(0, 1), b2 + hstep, voffB); PG8_STAGE(PG8_SA(0, 0), a2, voffA);
            PG8_WAIT_V(8); PG8_WAIT_L(0); PG8_BAR; PG8_MMA(1, 0, At, B0); PG8_MMA(1, 1, At, B1); PG8_BAR; PG8_SCHED;
            PG8_LDB(B0, 1, 0); PG8_LDB(B1, 1, 1); PG8_SCHED; PG8_LDA(At, 1, 0); PG8_STAGE(PG8_SA(0, 1), a2 + hstep, voffA);
            PG8_WAIT_V(8); PG8_WAIT_L(0); PG8_BAR; PG8_MMA(0, 0, At, B0); PG8_MMA(0, 1, At, B1); PG8_BAR; PG8_SCHED;
            PG8_LDA(At, 1, 1); PG8_STAGE(PG8_SB(1, 0), b3, voffB); PG8_STAGE(PG8_SB(1, 1), b3 + hstep, voffB); PG8_STAGE(PG8_SA(1, 0), a3, voffA);
            PG8_WAIT_V(8); PG8_WAIT_L(0); PG8_BAR; PG8_MMA(1, 0, At, B0); PG8_MMA(1, 1, At, B1); PG8_BAR; PG8_SCHED;
        }
        if (wr == 0) PG8_BAR;
        if constexpr (FP8) asm volatile("s_nop 15\n\ts_nop 15" ::: "memory");
        E(acc, cur, wr, wc, fr, fq);
        if (!has_next) break;
#pragma unroll
        for (int a = 0; a < 2; ++a)
#pragma unroll
            for (int b = 0; b < 2; ++b)
#pragma unroll
                for (int m = 0; m < 4; ++m)
#pragma unroll
                    for (int n = 0; n < 2; ++n) acc[a][b][m][n] = (f32x4){0.f, 0.f, 0.f, 0.f};
        cur = nxt; cA = nA; cB = nB; ++ui;
        if (wr == 1) PG8_BAR;
    }
    PG8_WAIT_V(0);
    PG8_BAR;
#undef PG8_SA
#undef PG8_SB
#undef PG8_STAGE
#undef PG8_LDA
#undef PG8_LDB
#undef PG8_MMA
#undef PG8_WAIT_V
#undef PG8_WAIT_L
#undef PG8_BAR
#undef PG8_SCHED
}
struct SchedStd {
    const char* A; const char* Bt; int K, nM, nN, G, c; size_t bgroup;
    __device__ __forceinline__ bool next(int i, Unit& u) const {
        const long Lid = (long)i * G + c; if (Lid >= (long)nM * nN) return false;
        tile_of((int)Lid, nM, nN, u.pm, u.pn); u.kind = 0;
        u.A = A + (size_t)u.pm * 256 * K * 2; u.B = Bt + (size_t)(u.pm >> 3) * bgroup + (size_t)u.pn * 256 * K * 2; return true;
    }
};
struct SchedIn {
    const char* HX; const char* WINT; int G, c;
    __device__ __forceinline__ bool next(int i, Unit& u) const {
        const long Lid = (long)i * G + c;
        if (Lid < 384) { tile_of((int)Lid, 6, 64, u.pm, u.pn); u.kind = 0; u.A = WINT + (size_t)u.pm * 256 * D * 2; u.B = HX + (size_t)u.pn * 256 * D * 2; return true; }
        if (Lid < 384 + 192) { tile_of((int)Lid - 384, 64, 3, u.pm, u.pn); u.kind = 1; u.A = HX + (size_t)u.pm * 256 * D * 2; u.B = WINT + (size_t)(OFF_Q + u.pn * 256) * D * 2; return true; }
        if (Lid < 384 + 192 + 8) { u.pm = 64 + (int)(Lid - 576); u.pn = 2; u.kind = 1; u.A = HX + (size_t)u.pm * 256 * D * 2; u.B = WINT + (size_t)(OFF_Q + 512) * D * 2; return true; }
        return false;
    }
};
struct SchedGate {
    const char* HX8; const char* WG8; int G, c;
    __device__ __forceinline__ bool next(int i, Unit& u) const {
        long Lid;
        if (G == 256) { if (i == 0) Lid = c; else if (i == 1 && c >= 72) Lid = 256 + (c - 72); else if (i == 2 && c >= 72 && c < 144) Lid = 440 + (c - 72); else return false; }
        else { Lid = (long)i * G + c; if (Lid >= 512) return false; }
        tile_of((int)Lid, 64, 8, u.pm, u.pn); u.kind = 1;
        u.A = HX8 + (size_t)u.pm * 256 * D; u.B = WG8 + (size_t)u.pn * 256 * D; u.pn += 3; return true;
    }
};
struct SchedP5 {
    const char* YA; const char* WAT; const char* YB; const char* WBT; int G, c;
    __device__ __forceinline__ bool next(int i, Unit& u) const {
        const long tile = (long)(i >> 1) * G + c; if (tile >= 256) return false;
        tile_of((int)tile, 64, 4, u.pm, u.pn); u.kind = i & 1;
        u.A = ((i & 1) ? YB : YA) + (size_t)u.pm * 256 * HW * 2; u.B = ((i & 1) ? WBT : WAT) + (size_t)u.pn * 256 * HW * 2; return true;
    }
};
}

struct UnitsStd {
    const bf16* A; const bf16* Bt; int lda, ldb, nM, nN; size_t bgroup;
    __device__ __forceinline__ bool get(int idx, int& pm, int& pn, const bf16*& Ab, const bf16*& Bb) const {
        if (idx >= nM * nN) return false;
        pm = idx / nN; pn = idx % nN;
        Ab = A + (size_t)pm * 256 * lda; Bb = Bt + (size_t)(pm >> 3) * bgroup + (size_t)pn * 256 * ldb; return true;
    }
};
struct UnitsIn {
    const bf16* A; const bf16* Bt;
    __device__ __forceinline__ bool get(int idx, int& pm, int& pn, const bf16*& Ab, const bf16*& Bb) const {
        if (idx < 64 * 11) { pm = idx / 11; pn = idx % 11; }
        else if (idx < 64 * 11 + 8) { pm = 64 + (idx - 64 * 11); pn = 2; }
        else return false;
        Ab = A + (size_t)pm * 256 * D; Bb = Bt + (size_t)pn * 256 * D; return true;
    }
};

struct EpiZ {
    bf16* ZT;
    __device__ __forceinline__ void st(int ch, int tok, const float* v) const { *(v4u*)(ZT + ((size_t)((tok >> 11) * 1536 + ch)) * 2048 + (tok & 2047)) = pack8(v); }
    __device__ __forceinline__ void operator()(int row, int pn, int c8, const float* v0, const float* v1) const { st(row, pn * 256 + c8, v0); st(row, pn * 256 + 128 + c8, v1); }
};
struct EpiIn {
    bf16 *Q, *Kr, *V, *KC, *VC; unsigned char *GA, *GB;
    __device__ __forceinline__ void one(int row, int n, const float* v) const {
        if (n < OFF_K) { if (row < M) *(v4u*)(Q + (size_t)row * QW + (n - OFF_Q)) = pack8(v); }
        else if (n < OFF_V) { if (row < M) *(v4u*)(Kr + (size_t)row * KVW + (n - OFF_K)) = pack8(v); else *(v4u*)(KC + (size_t)(row - M) * KVW + (n - OFF_K)) = pack8(v); }
        else if (n < OFF_G) { if (row < M) *(v4u*)(V + (size_t)row * KVW + (n - OFF_V)) = pack8(v); else *(v4u*)(VC + (size_t)(row - M) * KVW + (n - OFF_V)) = pack8(v); }
        else if (row < M) {
            unsigned q[8];
#pragma unroll
            for (int j = 0; j < 8; ++j) q[j] = (unsigned)(sigmf(v[j]) * 255.f + 0.5f);
            v2u w; w.x = q[0] | (q[1] << 8) | (q[2] << 16) | (q[3] << 24); w.y = q[4] | (q[5] << 8) | (q[6] << 16) | (q[7] << 24);
            if (n < OFF_G + D) *(v2u*)(GA + (size_t)row * D + (n - OFF_G)) = w; else *(v2u*)(GB + (size_t)row * D + (n - OFF_G - D)) = w;
        }
    }
    __device__ __forceinline__ void operator()(int row, int pn, int c8, const float* v0, const float* v1) const { one(row, OFF_Q + pn * 256 + c8, v0); one(row, OFF_Q + pn * 256 + 128 + c8, v1); }
};
struct EpiT1 {
    const unsigned char* GA; bf16* TA;
    __device__ __forceinline__ void one(int row, int n, const float* v) const {
        float g[8], o[8]; unpack8_u8(*(const v2u*)(GA + (size_t)row * D + n), g);
#pragma unroll
        for (int j = 0; j < 8; ++j) o[j] = g[j] * v[j];
        *(v4u*)(TA + (size_t)row * D + n) = pack8(o);
    }
    __device__ __forceinline__ void operator()(int row, int pn, int c8, const float* v0, const float* v1) const { one(row, pn * 256 + c8, v0); one(row, pn * 256 + 128 + c8, v1); }
};
struct EpiT2 {
    const unsigned char* GB; const bf16* TA; bf16* MMo;
    __device__ __forceinline__ void one(int row, int n, const float* v) const {
        float g[8], t[8], o[8]; unpack8_u8(*(const v2u*)(GB + (size_t)row * D + n), g); unpack8(*(const v4u*)(TA + (size_t)row * D + n), t);
#pragma unroll
        for (int j = 0; j < 8; ++j) o[j] = t[j] + g[j] * v[j];
        *(v4u*)(MMo + (size_t)row * D + n) = pack8(o);
    }
    __device__ __forceinline__ void operator()(int row, int pn, int c8, const float* v0, const float* v1) const { one(row, pn * 256 + c8, v0); one(row, pn * 256 + 128 + c8, v1); }
};
struct EpiOut {
    const float* x; const float* mod; float* out;
    __device__ __forceinline__ void one(int row, int n, const float* v) const {
        const float* g1 = mod + (size_t)(row >> 11) * MODW + 2 * D + n; const float* xr = x + (size_t)row * D + n; float* o = out + (size_t)row * D + n;
        const f32x4 x0 = *(const f32x4*)xr, x1 = *(const f32x4*)(xr + 4), ga = *(const f32x4*)g1, gb = *(const f32x4*)(g1 + 4);
        f32x4 o0, o1;
#pragma unroll
        for (int j = 0; j < 4; ++j) { o0[j] = x0[j] + ga[j] * v[j]; o1[j] = x1[j] + gb[j] * v[4 + j]; }
        *(f32x4*)o = o0; *(f32x4*)(o + 4) = o1;
    }
    __device__ __forceinline__ void operator()(int row, int pn, int c8, const float* v0, const float* v1) const { one(row, pn * 256 + c8, v0); one(row, pn * 256 + 128 + c8, v1); }
};
struct EpiH {
    unsigned char* HB;
    __device__ __forceinline__ void operator()(int row, int pn, int c8, const float* v0, const float* v1) const {
        float o[8];
#pragma unroll
        for (int j = 0; j < 8; ++j) o[j] = siluf(v0[j]) * v1[j];
        v2u w; w.x = pk4_fp8(o[0], o[1], o[2], o[3]); w.y = pk4_fp8(o[4], o[5], o[6], o[7]);
        *(v2u*)(HB + (size_t)row * DFF + pn * 128 + c8) = w;
    }
};
struct EpiY {
    const float* selg; const float* mod; unsigned char* Y;
    __device__ __forceinline__ void one(int row, int n, const float* v) const {
        const float g = selg[row] * 32.f; const float* g2 = mod + (size_t)((row >> 8) & 7) * MODW + 5 * D + n; float o[8];
#pragma unroll
        for (int j = 0; j < 8; ++j) o[j] = v[j] * g * g2[j];
        v2u w; w.x = pk4_fp8(o[0], o[1], o[2], o[3]); w.y = pk4_fp8(o[4], o[5], o[6], o[7]);
        *(v2u*)(Y + (size_t)row * D + n) = w;
    }
    __device__ __forceinline__ void operator()(int row, int pn, int c8, const float* v0, const float* v1) const { one(row, pn * 256 + c8, v0); one(row, pn * 256 + 128 + c8, v1); }
};
template <class F> struct K0 { F f; __device__ __forceinline__ void operator()(int kind, int row, int pn, int c8, const float* v0, const float* v1) const { f(row, pn, c8, v0, v1); } };
struct EpiP5 { EpiT1 t1; EpiT2 t2;
    __device__ __forceinline__ void operator()(int kind, int row, int pn, int c8, const float* v0, const float* v1) const { if (kind == 0) t1(row, pn, c8, v0, v1); else t2(row, pn, c8, v0, v1); } };
struct EpiP2 { EpiZ z; EpiIn in;
    __device__ __forceinline__ void operator()(int kind, int row, int pn, int c8, const float* v0, const float* v1) const { if (kind == 0) z(row, pn, c8, v0, v1); else in(row, pn, c8, v0, v1); } };

struct TrItem { const float* W; bf16* WT; int N, ldt, k0, n0, drow0, fp8; };
__device__ __forceinline__ void tr_load(const TrItem& T, int lane, f32x4 (&v)[8]) {
    const float* p = T.W + (size_t)(T.k0 + 8 * (lane & 7)) * T.N + T.n0 + 4 * (lane >> 3);
#pragma unroll
    for (int j = 0; j < 8; ++j) v[j] = __builtin_nontemporal_load((const f32x4*)(p + (size_t)j * T.N));
}
__device__ __forceinline__ void tr_store(const TrItem& T, int lane, const f32x4 (&v)[8]) {
    if (T.fp8) {
        unsigned char* q = (unsigned char*)T.WT + (size_t)(T.drow0 + 4 * (lane >> 3)) * T.ldt + T.k0 + 8 * (lane & 7);
#pragma unroll
        for (int i = 0; i < 4; ++i) { v2u o; o.x = pk4_fp8(32.f * v[0][i], 32.f * v[1][i], 32.f * v[2][i], 32.f * v[3][i]); o.y = pk4_fp8(32.f * v[4][i], 32.f * v[5][i], 32.f * v[6][i], 32.f * v[7][i]);
            *(v2u*)(q + (size_t)i * T.ldt) = o; }
    } else {
        bf16* q = T.WT + (size_t)(T.drow0 + 4 * (lane >> 3)) * T.ldt + T.k0 + 8 * (lane & 7);
#pragma unroll
        for (int i = 0; i < 4; ++i) { v4u o; o.x = pk2(v[0][i], v[1][i]); o.y = pk2(v[2][i], v[3][i]); o.z = pk2(v[4][i], v[5][i]); o.w = pk2(v[6][i], v[7][i]);
            *(v4u*)(q + (size_t)i * T.ldt) = o; }
    }
}
constexpr int TR_NITEMS = (D / 64) * (INW / 32) + 2 * (HW / 64) * (D / 32) + (D / 64) * (D / 32) + NE * (2 * (D / 64) * (DFF / 32) + (DFF / 64) * (D / 32));
constexpr int TR_TAIL = 112 * NWAVES * 4;
constexpr int TR_SL_HY = 256 * NWAVES * 16;
constexpr int TR_SL_AT = 0;
constexpr int TR_SL_RP = 0;
constexpr int TR_SL_TT = 0;
constexpr int TR_SL_TK = 256 * NWAVES * 2;
constexpr int TR_P0 = TR_NITEMS - TR_TAIL - TR_SL_HY - TR_SL_AT - TR_SL_RP - TR_SL_TT - TR_SL_TK, TR_HY0 = TR_P0, TR_AT0 = TR_HY0 + TR_SL_HY, TR_RP0 = TR_AT0 + TR_SL_AT, TR_TT0 = TR_RP0 + TR_SL_RP, TR_TK0 = TR_TT0 + TR_SL_TT;
static_assert(TR_P0 >= (D / 64) * (INW / 32) + 2 * (HW / 64) * (D / 32) + (D / 64) * (D / 32), "prologue slice covers the non-expert weights");
__device__ __forceinline__ bool tr_item(const Ctx& C, int it, TrItem& T) {
    constexpr int I_IN = (D / 64) * (INW / 32), I_A = (HW / 64) * (D / 32), I_O = (D / 64) * (D / 32), I_G = (D / 64) * (DFF / 32), I_D = (DFF / 64) * (D / 32);
    constexpr int NITEMS = I_IN + 2 * I_A + I_O + NE * (2 * I_G + I_D);
    if (it >= NITEMS || it < 0) return false;
    int r = it;
    if (r < I_IN) { const int nblk = INW / 32, kb = r / nblk, nbk = r % nblk;
        if (nbk * 32 < OFF_G) T = TrItem{C.in[IN_WIN], (bf16*)(C.ws + WS_WINT), INW, D, kb * 64, nbk * 32, nbk * 32, 0};
        else T = TrItem{C.in[IN_WIN], (bf16*)(C.ws + WS_WG8), INW, D, kb * 64, nbk * 32, nbk * 32 - OFF_G, 1};
        return true; } r -= I_IN;
    if (r < I_A) { const int nblk = D / 32, kb = r / nblk, nbk = r % nblk; T = TrItem{C.in[IN_WA], (bf16*)(C.ws + WS_WAT), D, HW, kb * 64, nbk * 32, nbk * 32, 0}; return true; } r -= I_A;
    if (r < I_A) { const int nblk = D / 32, kb = r / nblk, nbk = r % nblk; T = TrItem{C.in[IN_WB], (bf16*)(C.ws + WS_WBT), D, HW, kb * 64, nbk * 32, nbk * 32, 0}; return true; } r -= I_A;
    if (r < I_O) { const int nblk = D / 32, kb = r / nblk, nbk = r % nblk; T = TrItem{C.in[IN_WOUT], (bf16*)(C.ws + WS_WOUTT), D, D, kb * 64, nbk * 32, nbk * 32, 0}; return true; } r -= I_O;
    const int e = r / (2 * I_G + I_D); r -= e * (2 * I_G + I_D);
    if (r < 2 * I_G) { const int which = r / I_G; r -= which * I_G; const int nblk = DFF / 32, kb = r / nblk, nbk = r % nblk, f0 = nbk * 32;
        T = TrItem{(which ? C.in[IN_WUP] : C.in[IN_WGATE]) + (size_t)e * D * DFF, (bf16*)(C.ws + WS_W1T), DFF, D, kb * 64, f0, e * 4096 + 256 * (f0 >> 7) + 128 * which + (f0 & 127), 1}; return true; }
    r -= 2 * I_G;
    { const int nblk = D / 32, kb = r / nblk, nbk = r % nblk; T = TrItem{C.in[IN_WDOWN] + (size_t)e * DFF * D, (bf16*)(C.ws + WS_W2T), D, DFF, kb * 64, nbk * 32, e * 1024 + nbk * 32, 1}; return true; }
}
struct ConvSlice { int it, left; };
__device__ __forceinline__ ConvSlice conv_slice(const Ctx& C, int base, int per_wave) { ConvSlice q; q.it = base + (C.bid * NWAVES + C.wave) * per_wave; q.left = (C.nb == 256) ? per_wave : 0; return q; }
__device__ __forceinline__ void conv_flush(const Ctx& C, ConvSlice& q) {
    while (q.left > 0) { TrItem T; f32x4 v[8]; tr_item(C, q.it, T); tr_load(T, C.lane, v); tr_store(T, C.lane, v); q.it += 1; q.left -= 1; }
}

__device__ __forceinline__ void hx_rows(const Ctx& C);
__device__ __forceinline__ void p0_phase(const Ctx& C) {
    const int gw = C.bid * NWAVES + C.wave, NGW = C.nb * NWAVES, lane = C.lane;
    float* mod = (float*)(C.ws + WS_MOD);
    {
        LAS float* sc = (LAS float*)C.lds;
        LAS float* red = sc + 9 * 1024;
        for (int i = C.tid; i < 9 * 1024; i += NT) { const float v = (i < 8 * 1024) ? C.in[IN_C][i] : C.in[IN_CCTX][i - 8 * 1024]; sc[i] = siluf(v); }
        __syncthreads();
        for (int cb = C.bid; cb < MODW / 32; cb += C.nb) {
            const int cl = C.tid & 31, kg = C.tid >> 5, n = cb * 32 + cl;
            float a[9];
#pragma unroll
            for (int r = 0; r < 9; ++r) a[r] = 0.f;
#pragma unroll 1
            for (int k0 = kg; k0 < D; k0 += 16 * 16) {
                float w[16];
#pragma unroll
                for (int u = 0; u < 16; ++u) w[u] = __builtin_nontemporal_load(C.in[IN_ADAW] + (size_t)(k0 + 16 * u) * MODW + n);
#pragma unroll
                for (int u = 0; u < 16; ++u)
#pragma unroll
                    for (int r = 0; r < 9; ++r) a[r] += sc[r * 1024 + k0 + 16 * u] * w[u];
            }
#pragma unroll
            for (int r = 0; r < 9; ++r) red[(kg * 9 + r) * 32 + cl] = a[r];
            __syncthreads();
            if (C.tid < 9 * 32) { const int r = C.tid >> 5, c2 = C.tid & 31; float s = 0.f;
                for (int g = 0; g < 16; ++g) s += red[(g * 9 + r) * 32 + c2];
                mod[(size_t)r * MODW + cb * 32 + c2] = s + C.in[IN_ADAB][cb * 32 + c2]; }
            __syncthreads();
        }
    }
    sb_arrive((unsigned*)(C.ws + WS_CTL) + CW_SB0);
    {
        float* H3 = (float*)(C.ws + WS_H3);
        const double PI2 = 6.283185307179586476925286766559;
        for (int pos = gw; pos < L; pos += NGW) {
            double feat = 0.0;
            {
                const double t = (double)pos / (double)(L - 1), w = PI2 * (double)pos / (double)L;
                if (lane == 0) feat = t;
                else if (lane <= 32) { const int b = (lane - 1) & 15; const double fr = 1e-4 + (15.0 - 1e-4) * (double)b / 15.0; feat = (lane <= 16) ? cos(fr * w) : -sin(fr * w); }
            }
            const double fq = (double)C.in[IN_FFREQ][lane];
            double acc = (double)C.in[IN_FB1][lane];
            for (int k = 0; k < 33; ++k) acc += __shfl(feat, k) * (double)C.in[IN_FW1][k * 64 + lane];
            double h = sin(fq * acc);
            acc = (double)C.in[IN_FB2][lane];
            for (int k = 0; k < 64; ++k) acc += __shfl(h, k) * (double)C.in[IN_FW2][k * 64 + lane];
            h = sin(fq * acc);
            acc = (double)C.in[IN_FB3][lane];
            for (int k = 0; k < 64; ++k) acc += __shfl(h, k) * (double)C.in[IN_FW3][k * 64 + lane];
            h = sin(fq * acc);
            H3[(size_t)lane * L + pos] = (float)h;
        }
    }
    {
        float* R = (float*)(C.ws + WS_ROPE);
        for (int i = C.bid * NT + C.tid; i < L * 32; i += C.nb * NT) {
            const int pos = i >> 5, a = i & 31; const int m = a & 15;
            const double inv = pow(10000.0, -(double)m / 16.0);
            const double p = (a < 16) ? (double)(pos >> 6) : (double)(pos & 63);
            const double ang = p * inv;
            R[2 * i] = (float)cos(ang); R[2 * i + 1] = (float)sin(ang);
        }
    }
    {
        TrItem Ta, Tb; f32x4 va[8], vb[8];
        for (int it = gw; ; it += 2 * NGW) {
            const int lim = (C.nb == 256) ? TR_P0 : TR_NITEMS;
            const bool ha = (it < lim) && tr_item(C, it, Ta), hb = (it + NGW < lim) && tr_item(C, it + NGW, Tb);
            if (!ha) break;
            tr_load(Ta, lane, va); if (hb) tr_load(Tb, lane, vb);
            tr_store(Ta, lane, va); if (hb) tr_store(Tb, lane, vb);
        }
    }
    sb_wait((unsigned*)(C.ws + WS_CTL) + CW_SB0, (unsigned)C.nb, (unsigned*)(C.ws + WS_CTL) + CW_BAR + XB_TMO);
    hx_rows(C);
}

__device__ __forceinline__ void tap_table(const Ctx& C) {
    {
        const float* H3T = (const float*)(C.ws + WS_H3); bf16* GT = (bf16*)(C.ws + WS_GTAB);
        const float min_decay = -3.0701134573253946f, max_decay = -15.350567286626973f;
        ConvSlice tq = conv_slice(C, TR_TT0, 0);
        for (int c0 = C.bid; c0 < HW / 2; c0 += C.nb) {
            float a[2][4][4];
#pragma unroll
            for (int cc = 0; cc < 2; ++cc)
#pragma unroll
                for (int kk = 0; kk < 4; ++kk)
#pragma unroll
                    for (int q = 0; q < 4; ++q) a[cc][kk][q] = 0.f;
            const float* fo = C.in[IN_FOUT] + c0;
#pragma unroll 1
            for (int kq = 0; kq < 4; ++kq) {
            TrItem Ta; f32x4 cva[8]; const bool cv = tq.left > 0;
            if (cv) { tr_item(C, tq.it, Ta); tr_load(Ta, C.lane, cva); }
#pragma unroll 16
            for (int k = kq * 16; k < kq * 16 + 16; ++k) {
                float hv[4];
#pragma unroll
                for (int kk = 0; kk < 4; ++kk) hv[kk] = H3T[(size_t)k * L + C.tid + 512 * kk];
#pragma unroll
                for (int cc = 0; cc < 2; ++cc)
#pragma unroll
                    for (int q = 0; q < 4; ++q) { const float f = fo[(size_t)k * 2048 + q * 512 + cc * 256];
#pragma unroll
                        for (int kk = 0; kk < 4; ++kk) a[cc][kk][q] += hv[kk] * f; }
            }
            if (cv) { tr_store(Ta, C.lane, cva); tq.it += 1; tq.left -= 1; }
            }
#pragma unroll
            for (int cc = 0; cc < 2; ++cc) {
                const int c = c0 + cc * 256;
                const float delta = fabsf(min_decay + (max_decay - min_decay) * (float)c / 511.f);
#pragma unroll
                for (int kk = 0; kk < 4; ++kk) {
                    const int t = C.tid + 512 * kk;
                    const float dec = expf(-((float)t / (float)(L - 1)) * delta);
#pragma unroll
                    for (int o = 0; o < 2; ++o) {
                        float f = a[cc][kk][o * 2] * dec, bk = a[cc][kk][o * 2 + 1] * dec;
                        if (t == 0) f += C.in[IN_HBIAS][o * 512 + c];
                        bf16* g = GT + ((size_t)c * 2 + o) * GT_LEN;
                        g[2047 - t] = (bf16)f2bf(f); if (t == 0) g[4095] = (bf16)0; else g[2047 + t] = (bf16)f2bf(bk);
                    }
                }
            }
        }
            conv_flush(C, tq);
    }
}

__device__ __forceinline__ void hx_rows(const Ctx& C) {
    const int gw = C.bid * NWAVES + C.wave, NGW = C.nb * NWAVES, lane = C.lane;
    const float* mod = (const float*)(C.ws + WS_MOD);
    bf16* HX = (bf16*)(C.ws + WS_HX); unsigned char* HX8 = (unsigned char*)(C.ws + WS_HX8);
    for (int row0 = gw * 4; row0 < MT; row0 += NGW * 4) {
        const float* xr = (row0 < M) ? C.in[IN_X] + (size_t)row0 * D : C.in[IN_CTX] + (size_t)(row0 - M) * D;
        const int mb = (row0 < M) ? (row0 >> 11) : 8;
        const float* sh = mod + (size_t)mb * MODW; const float* sc = sh + D;
        f32x4 v[4][4]; float ss[4];
#pragma unroll
        for (int r = 0; r < 4; ++r)
#pragma unroll
            for (int j = 0; j < 4; ++j) v[r][j] = __builtin_nontemporal_load((const f32x4*)(xr + (size_t)r * D + 4 * lane + 256 * j));
#pragma unroll
        for (int r = 0; r < 4; ++r) { float s2 = 0.f;
#pragma unroll
            for (int j = 0; j < 4; ++j) s2 += (v[r][j][0] * v[r][j][0] + v[r][j][1] * v[r][j][1]) + (v[r][j][2] * v[r][j][2] + v[r][j][3] * v[r][j][3]);
            ss[r] = 1.f / sqrtf(wave_sum(s2) * (1.f / D) + EPS); }
#pragma unroll
        for (int j = 0; j < 4; ++j) {
            const int c0 = 4 * lane + 256 * j; const f32x4 g = *(const f32x4*)(C.in[IN_NORM1] + c0), a = *(const f32x4*)(sc + c0), b = *(const f32x4*)(sh + c0);
            float gm[4];
#pragma unroll
            for (int i = 0; i < 4; ++i) gm[i] = g[i] * (1.f + a[i]);
#pragma unroll
            for (int r = 0; r < 4; ++r) {
                float o[4];
#pragma unroll
                for (int i = 0; i < 4; ++i) o[i] = v[r][j][i] * ss[r] * gm[i] + b[i];
                v2u w; w.x = pk2(o[0], o[1]); w.y = pk2(o[2], o[3]);
                *(v2u*)(HX + (size_t)(row0 + r) * D + c0) = w;
                if (row0 < M) *(unsigned*)(HX8 + (size_t)(row0 + r) * D + c0) = pk4_fp8(o[0], o[1], o[2], o[3]);
            }
        }
    }
}
__device__ __forceinline__ void p1_phase(const Ctx& C) { if (C.nb != 256) tap_table(C); }

__device__ __forceinline__ float conv3(const bf16* u, int t, float w0, float w1, float w2, float cb) {
    const float a = (t > 0) ? bf2f(u[t - 1]) : 0.f, b = bf2f(u[t]), c = (t < L - 1) ? bf2f(u[t + 1]) : 0.f;
    return a * w0 + b * w1 + c * w2 + cb;
}
__device__ __forceinline__ void hyena_naive(const Ctx& C, int c) {
    const bf16* ZT = (const bf16*)(C.ws + WS_ZT); const bf16* GT = (const bf16*)(C.ws + WS_GTAB); bf16* YA = (bf16*)(C.ws + WS_YA);
    LAS float* G = (LAS float*)C.lds;
    LAS bf16* y0 = (LAS bf16*)(G + 4096);
    LAS bf16* y1 = y0 + 8 * 2048;
    const float* cw = C.in[IN_CONVW]; const float* cb = C.in[IN_CONVB];
    __syncthreads();
    for (int i = C.tid; i < 8 * 2048; i += NT) { const int b = i >> 11, t = i & 2047;
        y0[i] = (bf16)f2bf(conv3(ZT + ((size_t)b * 1536 + c) * 2048, t, cw[c], cw[1536 + c], cw[3072 + c], cb[c])); }
    for (int o = 0; o < 2; ++o) {
        LAS bf16* yi = o ? y1 : y0;
        for (int i = C.tid; i < 4096; i += NT) G[i] = bf2f(GT[((size_t)c * 2 + o) * GT_LEN + 4095 - i]);
        __syncthreads();
        const int gc = 512 * (o + 1) + c;
        float acc[4][8];
#pragma unroll
        for (int k = 0; k < 4; ++k)
#pragma unroll
            for (int b = 0; b < 8; ++b) acc[k][b] = 0.f;
        for (int s = 0; s < L; ++s) {
            float yv[8];
#pragma unroll
            for (int b = 0; b < 8; ++b) yv[b] = bf2f(yi[b * 2048 + s]);
#pragma unroll
            for (int k = 0; k < 4; ++k) { const float g = G[2048 + C.tid + 512 * k - s];
#pragma unroll
                for (int b = 0; b < 8; ++b) acc[k][b] += g * yv[b]; }
        }
#pragma unroll
        for (int k = 0; k < 4; ++k)
#pragma unroll
            for (int b = 0; b < 8; ++b) { const int t = C.tid + 512 * k;
                const float gate = conv3(ZT + ((size_t)b * 1536 + gc) * 2048, t, cw[gc], cw[1536 + gc], cw[3072 + gc], cb[gc]);
                const float r = gate * acc[k][b];
                if (o == 0) y1[b * 2048 + t] = (bf16)f2bf(r); else YA[((size_t)b * 2048 + t) * HW + c] = (bf16)f2bf(r); }
        __syncthreads();
    }
}


typedef float f32x16 __attribute__((ext_vector_type(16)));
constexpr int HY_YROW = 4496, HY_Y0 = 0, HY_Y1 = 35968, HY_TAP = 71936, HY_CS = 8256, HY_TMP = 137984;
static_assert(HY_TMP + 8192 + 16 <= MISC_OFF, "hyena LDS map");
template <int ORDER>
__device__ __forceinline__ void hyena_conv(const Ctx& C, int c, ConvSlice& cq) {
    const bf16* ZT = (const bf16*)(C.ws + WS_ZT); bf16* YAT = (bf16*)(C.ws + WS_YAT);
    const float* cw = C.in[IN_CONVW]; const float* cbp = C.in[IN_CONVB];
    const int w = C.wave, lane = C.lane, p = lane & 31, h = lane >> 5;
    const int m = 7 - (p & 7), pa = p >> 3, il = p & 3, b = p >> 2;
    const int yin = ORDER ? HY_Y1 : HY_Y0;
    const int dlo = 8 * w - 63;
    const int I0 = 2 * w;
    const int gc = 512 * (ORDER + 1) + c;
    const bf16* ug = ZT + ((size_t)b * 1536 + gc) * 2048;
    v2u gmid[2][4]; unsigned ghalo[2][4];
#pragma unroll
    for (int tile = 0; tile < 2; ++tile)
#pragma unroll
        for (int g = 0; g < 4; ++g) {
            const int t0 = 32 * (4 * (I0 + tile) + il) + 8 * g + 4 * h;
            gmid[tile][g] = *(const v2u*)(ug + t0);
            { const unsigned short x = ug[t0 > 0 ? t0 - 1 : 0], y = ug[t0 + 4 < L ? t0 + 4 : L - 1]; ghalo[tile][g] = ((t0 > 0) ? (unsigned)x : 0u) | (((t0 + 4 < L) ? (unsigned)y : 0u) << 16); }
        }
    TrItem Ta; f32x4 cva[8]; bool cv = cq.left >= 1;
    if (cv) { tr_item(C, cq.it, Ta); tr_load(Ta, lane, cva); }
    const LAS unsigned char* ap = C.lds + HY_TAP + m * HY_CS + 16 * (255 - pa + h) - 64 * dlo;
    const LAS unsigned char* bp0 = C.lds + yin + b * HY_YROW + 2 * (96 + 32 * (4 * I0 + il) + 8 * h) - 64 * dlo;
    f32x16 acc0, acc1;
#pragma unroll
    for (int i = 0; i < 16; ++i) { acc0[i] = 0.f; acc1[i] = 0.f; }
#define HY_LD(p) (*(const LAS bf16x8*)(p))
#define HY_MMA(a, b, c) c = __builtin_amdgcn_mfma_f32_32x32x16_bf16(a, b, c, 0, 0, 0)
#define HY_STEPA { const bf16x8 a0 = HY_LD(ap), a1 = HY_LD(ap + 32), b0 = HY_LD(bp0), b1 = HY_LD(bp0 + 32); HY_MMA(a0, b0, acc0); HY_MMA(a1, b1, acc0); ap -= 64; bp0 -= 64; }
#define HY_STEPB { const bf16x8 a0 = HY_LD(ap), a1 = HY_LD(ap + 32), n0 = HY_LD(bp0), n1 = HY_LD(bp0 + 32), m0 = HY_LD(bp0 + 256), m1 = HY_LD(bp0 + 288); \
        HY_MMA(a0, n0, acc0); HY_MMA(a0, m0, acc1); HY_MMA(a1, n1, acc0); HY_MMA(a1, m1, acc1); ap -= 64; bp0 -= 64; }
#define HY_STEPC { const bf16x8 a0 = HY_LD(ap), a1 = HY_LD(ap + 32), m0 = HY_LD(bp0 + 256), m1 = HY_LD(bp0 + 288); HY_MMA(a0, m0, acc1); HY_MMA(a1, m1, acc1); ap -= 64; bp0 -= 64; }
    HY_STEPA HY_STEPA HY_STEPA HY_STEPA
    if (!(C.sub & 16)) {
#pragma unroll 1
    for (int it = 0; it < 21; ++it) {
        if ((it == 5 || it == 10 || it == 15) && cv) { tr_store(Ta, lane, cva); cq.it += 1; cq.left -= 1; cv = cq.left >= 1; if (cv) { tr_item(C, cq.it, Ta); tr_load(Ta, lane, cva); } }
        HY_STEPB HY_STEPB HY_STEPB }
    }
    HY_STEPC HY_STEPC HY_STEPC HY_STEPC
#undef HY_LD
#undef HY_MMA
#undef HY_STEPA
#undef HY_STEPB
#undef HY_STEPC
    if (cv) { tr_store(Ta, lane, cva); cq.it += 1; cq.left -= 1; }
    if (C.sub & 64) return;
    const float w0 = cw[gc], w1 = cw[1536 + gc], w2 = cw[3072 + gc], cb = cbp[gc];
#pragma unroll
    for (int tile = 0; tile < 2; ++tile) {
#pragma unroll
        for (int g = 0; g < 4; ++g) {
            const int t0 = 32 * (4 * (I0 + tile) + il) + 8 * g + 4 * h;
            const v2u mid = gmid[tile][g];
            const float um1 = bflo(ghalo[tile][g]), up4 = bfhi(ghalo[tile][g]);
            const float u0 = bflo(mid.x), u1 = bfhi(mid.x), u2 = bflo(mid.y), u3 = bfhi(mid.y);
            float r[4];
            r[0] = (um1 * w0 + u0 * w1 + u1 * w2 + cb) * (tile ? acc1[4 * g + 0] : acc0[4 * g + 0]);
            r[1] = (u0 * w0 + u1 * w1 + u2 * w2 + cb) * (tile ? acc1[4 * g + 1] : acc0[4 * g + 1]);
            r[2] = (u1 * w0 + u2 * w1 + u3 * w2 + cb) * (tile ? acc1[4 * g + 2] : acc0[4 * g + 2]);
            r[3] = (u2 * w0 + u3 * w1 + up4 * w2 + cb) * (tile ? acc1[4 * g + 3] : acc0[4 * g + 3]);
            v2u o; o.x = pk2(r[0], r[1]); o.y = pk2(r[2], r[3]);
            if (ORDER == 0) *(LAS v2u*)(C.lds + HY_Y1 + b * HY_YROW + 2 * (96 + t0)) = o;
            else *(v2u*)(YAT + ((size_t)c * 8 + b) * 2048 + t0) = o;
        }
    }
}
struct HyPre { v4u u[4]; unsigned short um1[4], up8[4]; v4u taps; };
__device__ __forceinline__ void hyena_prefetch(const Ctx& C, int c, HyPre& P) {
    const bf16* ZT = (const bf16*)(C.ws + WS_ZT); const bf16* GT = (const bf16*)(C.ws + WS_GTAB);
#pragma unroll
    for (int k = 0; k < 4; ++k) {
        const int ci = C.tid + 512 * k, b = ci >> 8, t0 = (ci & 255) * 8;
        const bf16* u = ZT + ((size_t)b * 1536 + c) * 2048;
        P.u[k] = *(const v4u*)(u + t0); { const unsigned short x = u[t0 > 0 ? t0 - 1 : 0], y = u[t0 + 8 < L ? t0 + 8 : L - 1]; P.um1[k] = (t0 > 0) ? x : (unsigned short)0; P.up8[k] = (t0 + 8 < L) ? y : (unsigned short)0; }
    }
    P.taps = *(const v4u*)(GT + ((size_t)c * 2 + 0) * GT_LEN + C.tid * 8);
}
__device__ __forceinline__ void hyena_taps_fill(const Ctx& C, v4u traw) {
    LAS unsigned char* tmp = C.lds + HY_TMP;
    *(LAS v4u*)(tmp + C.tid * 16) = traw;
    if (C.tid == 0) *(LAS v4u*)(tmp + 8192) = (v4u){0u, 0u, 0u, 0u};
    LDS_BARRIER();
    const v4u hi = *(const LAS v4u*)(tmp + C.tid * 16 + 16);
    const unsigned d[8] = {traw.x, traw.y, traw.z, traw.w, hi.x, hi.y, hi.z, hi.w};
#pragma unroll
    for (int m = 0; m < 8; ++m) {
        v4u w;
        if (m & 1) { w.x = __builtin_amdgcn_alignbit(d[(m >> 1) + 1], d[(m >> 1)], 16); w.y = __builtin_amdgcn_alignbit(d[(m >> 1) + 2], d[(m >> 1) + 1], 16);
                     w.z = __builtin_amdgcn_alignbit(d[(m >> 1) + 3], d[(m >> 1) + 2], 16); w.w = __builtin_amdgcn_alignbit(d[(m >> 1) + 4], d[(m >> 1) + 3], 16); }
        else { w.x = d[m >> 1]; w.y = d[(m >> 1) + 1]; w.z = d[(m >> 1) + 2]; w.w = d[(m >> 1) + 3]; }
        *(LAS v4u*)(C.lds + HY_TAP + m * HY_CS + C.tid * 16) = w;
    }
    LDS_BARRIER();
}
__device__ __forceinline__ void hyena_fast(const Ctx& C, int c, int cnext, ConvSlice& cq) {
    HyPre P; hyena_prefetch(C, c, P);
    const bf16* GT = (const bf16*)(C.ws + WS_GTAB);
    const float* cw = C.in[IN_CONVW]; const float* cbp = C.in[IN_CONVB];
    LDS_BARRIER();
    {
        const float w0 = cw[c], w1 = cw[1536 + c], w2 = cw[3072 + c], cb = cbp[c];
#pragma unroll
        for (int k = 0; k < 4; ++k) {
            const int ci = C.tid + 512 * k, b = ci >> 8, t0 = (ci & 255) * 8;
            float f[10]; unpack8(P.u[k], f + 1);
            f[0] = bf2f(P.um1[k]); f[9] = bf2f(P.up8[k]);
            float o[8];
#pragma unroll
            for (int j = 0; j < 8; ++j) o[j] = f[j] * w0 + f[j + 1] * w1 + f[j + 2] * w2 + cb;
            *(LAS v4u*)(C.lds + HY_Y0 + b * HY_YROW + 2 * (96 + t0)) = pack8(o);
        }
    }
    const v4u t1raw = *(const v4u*)(GT + ((size_t)c * 2 + 1) * GT_LEN + C.tid * 8);
    if (!(C.sub & 32)) hyena_taps_fill(C, P.taps);
    hyena_conv<0>(C, c, cq);
    LDS_BARRIER();
    if (!(C.sub & 32)) hyena_taps_fill(C, t1raw);
    hyena_conv<1>(C, c, cq);
}
__device__ __forceinline__ void hyena_zero_pads(const Ctx& C) {
    for (int i = C.tid; i < 2 * 8 * 100; i += NT) {
        const int buf = i / 800, r = (i % 800) / 100, k = i % 100;
        const int e = (k < 48) ? 2 * k : 2144 + 2 * (k - 48);
        *(LAS unsigned*)(C.lds + (buf ? HY_Y1 : HY_Y0) + r * HY_YROW + 2 * e) = 0u;
    }
    __syncthreads();
}

__device__ __forceinline__ void attn_naive(const Ctx& C, int item) {
    const int b = item >> 5, kvh = (item >> 4) & 1, qb = item & 15;
    const bf16* Q = (const bf16*)(C.ws + WS_QRAW); const bf16* Kr = (const bf16*)(C.ws + WS_KRAW); const bf16* V = (const bf16*)(C.ws + WS_VB);
    const bf16* KC = (const bf16*)(C.ws + WS_KC); const bf16* VC = (const bf16*)(C.ws + WS_VC); bf16* YB = (bf16*)(C.ws + WS_YB);
    const float* rope = (const float*)(C.ws + WS_ROPE);
    LAS float* Ks = (LAS float*)C.lds;
    LAS float* Vs = Ks + 128 * 64;
    const int g = C.tid >> 7, qi = C.tid & 127, h = kvh * 4 + g, t = qb * 128 + qi;
    float q[64];
    {
        const bf16* qr = Q + ((size_t)b * L + t) * QW + h * 64; float ss = 0.f;
#pragma unroll
        for (int j = 0; j < 8; ++j) { unpack8(*(const v4u*)(qr + 8 * j), q + 8 * j); }
#pragma unroll
        for (int d = 0; d < 64; ++d) ss += q[d] * q[d];
        const float rs = 1.f / sqrtf(ss * (1.f / 64.f) + EPS);
#pragma unroll
        for (int i = 0; i < 32; ++i) { const float cs = rope[((size_t)t * 32 + i) * 2], sn = rope[((size_t)t * 32 + i) * 2 + 1];
            const float xe = q[2 * i] * rs * C.in[IN_QNORM][2 * i], xo = q[2 * i + 1] * rs * C.in[IN_QNORM][2 * i + 1];
            q[2 * i] = rbf((xe * cs - xo * sn) * 0.125f); q[2 * i + 1] = rbf((xe * sn + xo * cs) * 0.125f); }
    }
    float mrun = -1e30f, lrun = 0.f, o[64];
#pragma unroll
    for (int d = 0; d < 64; ++d) o[d] = 0.f;
    for (int ch = 0; ch < 5; ++ch) {
        const int kblk = qb - 1 + ch;
        if (ch < 3 && (kblk < 0 || kblk >= 16)) continue;
        __syncthreads();
        {
            const int key = C.tid >> 2, part = C.tid & 3;
            const bf16* kr; const bf16* vr; int pos = 0;
            if (ch < 3) { pos = kblk * 128 + key; kr = Kr + ((size_t)b * L + pos) * KVW + kvh * 64 + part * 16; vr = V + ((size_t)b * L + pos) * KVW + kvh * 64 + part * 16; }
            else { const int cp = (ch - 3) * 128 + key; kr = KC + ((size_t)b * LC + cp) * KVW + kvh * 64 + part * 16; vr = VC + ((size_t)b * LC + cp) * KVW + kvh * 64 + part * 16; }
            float kf[16], vf[16];
            unpack8(*(const v4u*)kr, kf); unpack8(*(const v4u*)(kr + 8), kf + 8); unpack8(*(const v4u*)vr, vf); unpack8(*(const v4u*)(vr + 8), vf + 8);
            float ss = 0.f;
#pragma unroll
            for (int d = 0; d < 16; ++d) ss += kf[d] * kf[d];
            ss += __shfl_xor(ss, 1); ss += __shfl_xor(ss, 2);
            const float rs = 1.f / sqrtf(ss * (1.f / 64.f) + EPS);
#pragma unroll
            for (int i = 0; i < 8; ++i) {
                const int pi = part * 8 + i;
                float xe = kf[2 * i] * rs * C.in[IN_KNORM][2 * pi], xo = kf[2 * i + 1] * rs * C.in[IN_KNORM][2 * pi + 1];
                if (ch < 3) { const float cs = rope[((size_t)pos * 32 + pi) * 2], sn = rope[((size_t)pos * 32 + pi) * 2 + 1]; const float a = xe * cs - xo * sn, bb = xe * sn + xo * cs; xe = a; xo = bb; }
                Ks[key * 64 + part * 16 + 2 * i] = rbf(xe); Ks[key * 64 + part * 16 + 2 * i + 1] = rbf(xo);
            }
#pragma unroll
            for (int d = 0; d < 16; ++d) Vs[key * 64 + part * 16 + d] = vf[d];
        }
        __syncthreads();
        for (int key = 0; key < 128; ++key) {
            if (ch < 3) { const int s = kblk * 128 + key; const int df = t - s; if (df > 128 || df < -128) continue; }
            float sc = 0.f;
#pragma unroll
            for (int d = 0; d < 64; ++d) sc += q[d] * Ks[key * 64 + d];
            const float mn = fmaxf(mrun, sc), al = __expf(mrun - mn), p = __expf(sc - mn);
            lrun = lrun * al + p; mrun = mn;
#pragma unroll
            for (int d = 0; d < 64; ++d) o[d] = o[d] * al + p * Vs[key * 64 + d];
        }
    }
    {
        const float sk = C.in[IN_SINK][h]; const float mn = fmaxf(mrun, sk), al = __expf(mrun - mn);
        lrun = lrun * al + __expf(sk - mn); const float inv = al / lrun;
        bf16* yr = YB + ((size_t)b * L + t) * QW + h * 64;
#pragma unroll
        for (int j = 0; j < 8; ++j) { float v[8];
#pragma unroll
            for (int d = 0; d < 8; ++d) v[d] = o[8 * j + d] * inv;
            *(v4u*)(yr + 8 * j) = pack8(v); }
    }
}


__device__ __forceinline__ void ya_transpose(const Ctx& C) {
    const bf16* YAT = (const bf16*)(C.ws + WS_YAT); bf16* YA = (bf16*)(C.ws + WS_YA);
    constexpr int RS = 144;
    for (int blk = C.bid; blk < M / 64; blk += C.nb) {
        const int tok0 = blk * 64, b = tok0 >> 11, t0 = tok0 & 2047;
        __syncthreads();
#pragma unroll
        for (int p = 0; p < 8; ++p) { const int c = (C.tid >> 3) + 64 * p, seg = C.tid & 7;
            *(LAS v4u*)(C.lds + c * RS + seg * 16) = *(const v4u*)(YAT + ((size_t)c * 8 + b) * 2048 + t0 + 8 * seg); }
        __syncthreads();
#pragma unroll 2
        for (int k = 0; k < 8; ++k) { const int tt = C.wave + 8 * k; unsigned e[8];
#pragma unroll
            for (int j = 0; j < 8; ++j) e[j] = *(const LAS bf16*)(C.lds + (8 * C.lane + j) * RS + tt * 2);
            v4u w; w.x = e[0] | (e[1] << 16); w.y = e[2] | (e[3] << 16); w.z = e[4] | (e[5] << 16); w.w = e[6] | (e[7] << 16);
            *(v4u*)(YA + (size_t)(tok0 + tt) * HW + 8 * C.lane) = w; }
    }
}

constexpr int AT_KS = 0, AT_KROW = 144, AT_VT = 128 * 144, AT_VROW = 264;
__device__ __forceinline__ void attn_fast(const Ctx& C, int item) {
    const int b = item >> 5, kvh = (item >> 4) & 1, qb = item & 15;
    const bf16* Q = (const bf16*)(C.ws + WS_QRAW); const bf16* Kr = (const bf16*)(C.ws + WS_KRAW); const bf16* V = (const bf16*)(C.ws + WS_VB);
    const bf16* KC = (const bf16*)(C.ws + WS_KC); const bf16* VC = (const bf16*)(C.ws + WS_VC); bf16* YB = (bf16*)(C.ws + WS_YB);
    const float* rope = (const float*)(C.ws + WS_ROPE);
    const int w = C.wave, g = w >> 1, qh = w & 1, hd = kvh * 4 + g, lane = C.lane, q = lane & 31, h = lane >> 5;
    bf16x8 qf[2][4];
#pragma unroll
    for (int qt = 0; qt < 2; ++qt) {
        const int t = qb * 128 + qh * 64 + qt * 32 + q;
        const bf16* qr = Q + ((size_t)b * L + t) * QW + hd * 64;
        float x[32]; float ss = 0.f;
#pragma unroll
        for (int ks = 0; ks < 4; ++ks) unpack8(*(const v4u*)(qr + 16 * ks + 8 * h), x + 8 * ks);
#pragma unroll
        for (int i = 0; i < 32; ++i) ss += x[i] * x[i];
        ss += __shfl_xor(ss, 32);
        const float rs = 1.f / sqrtf(ss * (1.f / 64.f) + EPS);
#pragma unroll
        for (int ks = 0; ks < 4; ++ks) {
            unsigned wv[4];
#pragma unroll
            for (int jp = 0; jp < 4; ++jp) {
                const int dim = 16 * ks + 8 * h + 2 * jp, pi = dim >> 1;
                const f32x2_t cs = *(const f32x2_t*)(rope + ((size_t)t * 32 + pi) * 2);
                const float xe = x[8 * ks + 2 * jp] * rs * C.in[IN_QNORM][dim], xo = x[8 * ks + 2 * jp + 1] * rs * C.in[IN_QNORM][dim + 1];
                wv[jp] = cvtpk((xe * cs.x - xo * cs.y) * (0.125f * 1.4426950408889634f), (xe * cs.y + xo * cs.x) * (0.125f * 1.4426950408889634f));
            }
            v4u pk; pk.x = wv[0]; pk.y = wv[1]; pk.z = wv[2]; pk.w = wv[3];
            qf[qt][ks] = __builtin_bit_cast(bf16x8, pk);
        }
    }
    f32x16 O00, O01, O10, O11;
#pragma unroll
    for (int i = 0; i < 16; ++i) { O00[i] = 0.f; O01[i] = 0.f; O10[i] = 0.f; O11[i] = 0.f; }
    float mrun0 = -1e30f, mrun1 = -1e30f, lrun0 = 0.f, lrun1 = 0.f;
    const int skey = C.tid >> 2, spart = C.tid & 3;
    v4u rk0, rk1, rv0, rv1;
#define AT_CH(cc_) (((cc_) == 0) ? 1 : ((cc_) == 1 ? 0 : (cc_)))
#define AT_VALID(cc_) (!(AT_CH(cc_) < 3 && (qb - 1 + AT_CH(cc_) < 0 || qb - 1 + AT_CH(cc_) >= 16)))
#define AT_LOAD(cc_) do { const int ch_ = AT_CH(cc_); const bf16* kr_; const bf16* vr_; \
        if (ch_ < 3) { const int pos_ = (qb - 1 + ch_) * 128 + skey; kr_ = Kr + ((size_t)b * L + pos_) * KVW + kvh * 64 + spart * 16; vr_ = V + ((size_t)b * L + pos_) * KVW + kvh * 64 + spart * 16; } \
        else { const int cp_ = (ch_ - 3) * 128 + skey; kr_ = KC + ((size_t)b * LC + cp_) * KVW + kvh * 64 + spart * 16; vr_ = VC + ((size_t)b * LC + cp_) * KVW + kvh * 64 + spart * 16; } \
        rk0 = *(const v4u*)kr_; rk1 = *(const v4u*)(kr_ + 8); rv0 = *(const v4u*)vr_; rv1 = *(const v4u*)(vr_ + 8); } while (0)
    AT_LOAD(0);
    for (int cc = 0; cc < 5; ++cc) {
        const int ch = AT_CH(cc);
        const int kblk = qb - 1 + ch;
        if (!AT_VALID(cc)) continue;
        LDS_BARRIER();
        {
            const int key = skey, part = spart; const int pos = kblk * 128 + key;
            float kf[16];
            const v4u v0 = rv0, v1 = rv1;
            unpack8(rk0, kf); unpack8(rk1, kf + 8);
            float ss = 0.f;
#pragma unroll
            for (int d = 0; d < 16; ++d) ss += kf[d] * kf[d];
            ss += __shfl_xor(ss, 1); ss += __shfl_xor(ss, 2);
            const float rs = 1.f / sqrtf(ss * (1.f / 64.f) + EPS);
            unsigned wv[8];
#pragma unroll
            for (int i = 0; i < 8; ++i) {
                const int pi = part * 8 + i;
                float xe = kf[2 * i] * rs * C.in[IN_KNORM][2 * pi], xo = kf[2 * i + 1] * rs * C.in[IN_KNORM][2 * pi + 1];
                if (ch < 3) { const f32x2_t cs = *(const f32x2_t*)(rope + ((size_t)pos * 32 + pi) * 2); const float a = xe * cs.x - xo * cs.y, bb = xe * cs.y + xo * cs.x; xe = a; xo = bb; }
                wv[i] = cvtpk(xe, xo);
            }
            v4u k0; k0.x = wv[0]; k0.y = wv[1]; k0.z = wv[2]; k0.w = wv[3];
            v4u k1; k1.x = wv[4]; k1.y = wv[5]; k1.z = wv[6]; k1.w = wv[7];
            *(LAS v4u*)(C.lds + AT_KS + key * AT_KROW + part * 32) = k0; *(LAS v4u*)(C.lds + AT_KS + key * AT_KROW + part * 32 + 16) = k1;
            const unsigned vw[8] = {v0.x, v0.y, v0.z, v0.w, v1.x, v1.y, v1.z, v1.w};
#pragma unroll
            for (int j = 0; j < 8; ++j) {
                *(LAS bf16*)(C.lds + AT_VT + (part * 16 + 2 * j) * AT_VROW + key * 2) = (bf16)(vw[j] & 0xffffu);
                *(LAS bf16*)(C.lds + AT_VT + (part * 16 + 2 * j + 1) * AT_VROW + key * 2) = (bf16)(vw[j] >> 16);
            }
        }
        {
            int nc = cc + 1; while (nc < 5 && !AT_VALID(nc)) ++nc;
            if (nc < 5) AT_LOAD(nc);
        }
        LDS_BARRIER();
#pragma unroll 1
        for (int kt = 0; kt < 4; ++kt) {
            const bool sk0 = (ch == 0) ? (2 * qh + 0 > kt) : (ch == 2 ? (kt > 2 * qh + 0) : false);
            const bool sk1 = (ch == 0) ? (2 * qh + 1 > kt) : (ch == 2 ? (kt > 2 * qh + 1) : false);
            if (sk0 && sk1) continue;
            bf16x8 kfr[4];
#pragma unroll
            for (int ks = 0; ks < 4; ++ks) kfr[ks] = *(const LAS bf16x8*)(C.lds + AT_KS + (kt * 32 + q) * AT_KROW + ks * 32 + h * 16);
            bf16x8 vfr[2][2];
#pragma unroll
            for (int dt = 0; dt < 2; ++dt)
#pragma unroll
                for (int sI = 0; sI < 2; ++sI) {
                    const LAS unsigned char* vp = C.lds + AT_VT + (dt * 32 + q) * AT_VROW + (kt * 32 + 16 * sI + 4 * h) * 2;
                    const v2u lo = *(const LAS v2u*)vp, hi2 = *(const LAS v2u*)(vp + 16);
                    v4u pk; pk.x = lo.x; pk.y = lo.y; pk.z = hi2.x; pk.w = hi2.y;
                    vfr[dt][sI] = __builtin_bit_cast(bf16x8, pk);
                }
#pragma unroll
            for (int qt = 0; qt < 2; ++qt) {
                if (qt == 0 ? sk0 : sk1) continue;
                f32x16 sT;
#pragma unroll
                for (int i = 0; i < 16; ++i) sT[i] = 0.f;
#pragma unroll
                for (int ks = 0; ks < 4; ++ks) sT = __builtin_amdgcn_mfma_f32_32x32x16_bf16(kfr[ks], qf[qt][ks], sT, 0, 0, 0);
                if (ch == 0 || ch == 2) {
                    const int tq = qb * 128 + qh * 64 + qt * 32 + q;
#pragma unroll
                    for (int r = 0; r < 16; ++r) { const int sp = kblk * 128 + kt * 32 + (r & 3) + 8 * (r >> 2) + 4 * h; const int df = tq - sp; if (df > 128 || df < -128) sT[r] = -1e30f; }
                }
                float mx = sT[0];
#pragma unroll
                for (int r = 1; r < 16; ++r) mx = fmaxf(mx, sT[r]);
                mx = fmaxf(mx, __shfl_xor(mx, 32));
                const float mo = qt ? mrun1 : mrun0; const float mn = fmaxf(mo, mx), al = __builtin_amdgcn_exp2f(mo - mn);
                float rsum = 0.f; float pv[16];
#pragma unroll
                for (int r = 0; r < 16; ++r) { pv[r] = __builtin_amdgcn_exp2f(sT[r] - mn); rsum += pv[r]; }
                v4u p0, p1;
                p0.x = cvtpk(pv[0], pv[1]); p0.y = cvtpk(pv[2], pv[3]); p0.z = cvtpk(pv[4], pv[5]); p0.w = cvtpk(pv[6], pv[7]);
                p1.x = cvtpk(pv[8], pv[9]); p1.y = cvtpk(pv[10], pv[11]); p1.z = cvtpk(pv[12], pv[13]); p1.w = cvtpk(pv[14], pv[15]);
                const bf16x8 pf0 = __builtin_bit_cast(bf16x8, p0), pf1 = __builtin_bit_cast(bf16x8, p1);
                const bool grew = __any(mn > mo);
                if (qt == 0) {
                    mrun0 = mn; lrun0 = lrun0 * al + rsum;
                    if (grew) {
#pragma unroll
                    for (int i = 0; i < 16; ++i) { O00[i] *= al; O01[i] *= al; } }
                    O00 = __builtin_amdgcn_mfma_f32_32x32x16_bf16(vfr[0][0], pf0, O00, 0, 0, 0); O00 = __builtin_amdgcn_mfma_f32_32x32x16_bf16(vfr[0][1], pf1, O00, 0, 0, 0);
                    O01 = __builtin_amdgcn_mfma_f32_32x32x16_bf16(vfr[1][0], pf0, O01, 0, 0, 0); O01 = __builtin_amdgcn_mfma_f32_32x32x16_bf16(vfr[1][1], pf1, O01, 0, 0, 0);
                } else {
                    mrun1 = mn; lrun1 = lrun1 * al + rsum;
                    if (grew) {
#pragma unroll
                    for (int i = 0; i < 16; ++i) { O10[i] *= al; O11[i] *= al; } }
                    O10 = __builtin_amdgcn_mfma_f32_32x32x16_bf16(vfr[0][0], pf0, O10, 0, 0, 0); O10 = __builtin_amdgcn_mfma_f32_32x32x16_bf16(vfr[0][1], pf1, O10, 0, 0, 0);
                    O11 = __builtin_amdgcn_mfma_f32_32x32x16_bf16(vfr[1][0], pf0, O11, 0, 0, 0); O11 = __builtin_amdgcn_mfma_f32_32x32x16_bf16(vfr[1][1], pf1, O11, 0, 0, 0);
                }
            }
        }
    }
#undef AT_CH
#undef AT_VALID
#undef AT_LOAD
    const float sk = C.in[IN_SINK][hd] * 1.4426950408889634f;
#pragma unroll
    for (int qt = 0; qt < 2; ++qt) {
        const float mo = qt ? mrun1 : mrun0; float l = qt ? lrun1 : lrun0; l += __shfl_xor(l, 32);
        const float mn = fmaxf(mo, sk), al = __builtin_amdgcn_exp2f(mo - mn); l = l * al + __builtin_amdgcn_exp2f(sk - mn);
        const float inv = al / l;
        const int t = qb * 128 + qh * 64 + qt * 32 + q;
        bf16* yr = YB + ((size_t)b * L + t) * QW + hd * 64;
#pragma unroll
        for (int dt = 0; dt < 2; ++dt)
#pragma unroll
            for (int gq = 0; gq < 4; ++gq) {
                float v[4];
#pragma unroll
                for (int i = 0; i < 4; ++i) v[i] = (qt ? (dt ? O11[4 * gq + i] : O10[4 * gq + i]) : (dt ? O01[4 * gq + i] : O00[4 * gq + i])) * inv;
                v2u o; o.x = cvtpk(v[0], v[1]); o.y = cvtpk(v[2], v[3]);
                *(v2u*)(yr + dt * 32 + 8 * gq + 4 * h) = o;
            }
    }
}

__device__ __forceinline__ void p6_phase(const Ctx& C) {
    const int lane = C.lane;
    const float* mod = (const float*)(C.ws + WS_MOD); unsigned char* HX2 = (unsigned char*)(C.ws + WS_HX2); float* AFF = (float*)(C.ws + WS_AFF);
    LAS float* RT = (LAS float*)C.lds;
    LAS float* GM = RT + NE * D;
    LAS float* BB = GM + D;
    const float* XN = (const float*)(C.ws + WS_XNEW);
    __syncthreads();
    for (int i = C.tid; i < D * NE; i += NT) { const int k = i >> 4, e = i & 15; RT[e * D + k] = C.in[IN_ROUTER][i]; }
    for (int blk = C.bid; blk < M / 64; blk += C.nb) {
        const int mb = (blk * 64) >> 11;
        const float* sh = mod + (size_t)mb * MODW + 3 * D; const float* sc = sh + D;
        __syncthreads();
        for (int i = C.tid; i < D; i += NT) { GM[i] = C.in[IN_NORM2][i] * (1.f + sc[i]); BB[i] = sh[i]; }
        __syncthreads();
#pragma unroll 1
        for (int grp = 0; grp < 2; ++grp) {
            const int row0 = blk * 64 + C.wave * 8 + grp * 4;
            const float* xr = XN + (size_t)row0 * D + 4 * lane;
            float rstd[4];
            {
                f32x4 v[4][4];
#pragma unroll
                for (int r = 0; r < 4; ++r)
#pragma unroll
                    for (int j = 0; j < 4; ++j) v[r][j] = *(const f32x4*)(xr + (size_t)r * D + 256 * j);
#pragma unroll
                for (int r = 0; r < 4; ++r) { float s2 = 0.f;
#pragma unroll
                    for (int j = 0; j < 4; ++j) s2 += (v[r][j][0] * v[r][j][0] + v[r][j][1] * v[r][j][1]) + (v[r][j][2] * v[r][j][2] + v[r][j][3] * v[r][j][3]);
                    rstd[r] = 1.f / sqrtf(wave_sum(s2) * (1.f / D) + EPS); }
            }
            float lg[4][16];
#pragma unroll
            for (int r = 0; r < 4; ++r)
#pragma unroll
                for (int e = 0; e < 16; ++e) lg[r][e] = 0.f;
            f32x4 cur[4], nxt[4];
#pragma unroll
            for (int r = 0; r < 4; ++r) cur[r] = *(const f32x4*)(xr + (size_t)r * D);
#pragma unroll 1
            for (int j = 0; j < 4; ++j) {
                const int c0 = 4 * lane + 256 * j; const int jn = (j < 3) ? j + 1 : 3;
#pragma unroll
                for (int r = 0; r < 4; ++r) nxt[r] = *(const f32x4*)(xr + (size_t)r * D + 256 * jn);
                const f32x4 gm = *(const LAS f32x4*)(GM + c0), bb = *(const LAS f32x4*)(BB + c0);
                f32x4 o[4];
#pragma unroll
                for (int r = 0; r < 4; ++r) {
#pragma unroll
                    for (int i = 0; i < 4; ++i) o[r][i] = cur[r][i] * rstd[r] * gm[i] + bb[i];
                    *(unsigned*)(HX2 + (size_t)(row0 + r) * D + c0) = pk4_fp8(o[r][0], o[r][1], o[r][2], o[r][3]);
                }
#pragma unroll
                for (int e = 0; e < 16; ++e) { const f32x4 w = *(const LAS f32x4*)(RT + e * D + c0);
#pragma unroll
                    for (int r = 0; r < 4; ++r) lg[r][e] += (o[r][0] * w[0] + o[r][1] * w[1]) + (o[r][2] * w[2] + o[r][3] * w[3]); }
#pragma unroll
                for (int r = 0; r < 4; ++r) cur[r] = nxt[r];
            }
#pragma unroll
            for (int r = 0; r < 4; ++r) {
                float mx = -1e30f;
#pragma unroll
                for (int e = 0; e < 16; ++e) { lg[r][e] = wave_sum(lg[r][e]); mx = fmaxf(mx, lg[r][e]); }
                float den = 0.f;
#pragma unroll
                for (int e = 0; e < 16; ++e) { lg[r][e] = expf(lg[r][e] - mx); den += lg[r][e]; }
                if (lane < 16) { float val = 0.f;
#pragma unroll
                    for (int e = 0; e < 16; ++e) val = (lane == e) ? lg[r][e] : val;
                    AFF[((size_t)mb * 16 + lane) * L + ((row0 + r) & 2047)] = val / den; }
            }
        }
    }
}

__device__ __forceinline__ void p7_phase(const Ctx& C) {
    const float* AFF = (const float*)(C.ws + WS_AFF); int* SLOT = (int*)(C.ws + WS_SLOT); float* SELG = (float*)(C.ws + WS_SELG);
    const unsigned char* HX2 = (const unsigned char*)(C.ws + WS_HX2); unsigned char* XIN = (unsigned char*)(C.ws + WS_XIN);
    LAS unsigned long long* KY = (LAS unsigned long long*)C.lds;
    LAS int* rk = (LAS int*)(C.lds + 16384);
    ConvSlice kq = conv_slice(C, TR_TK0, 2);
    for (int it = C.bid; it < NB * NE * 2; it += C.nb) {
        const int item = it >> 1, half = it & 1, b = item >> 4, e = item & 15;
        __syncthreads();
        for (int t = C.tid; t < L; t += NT) {
            const unsigned bits = __builtin_bit_cast(unsigned, AFF[((size_t)b * 16 + e) * L + t]);
            KY[t] = ~(((unsigned long long)bits << 32) | (unsigned long long)(2047 - t)); rk[t] = -1;
        }
        __syncthreads();
        TrItem Ta, Tb; f32x4 cva[8], cvb[8]; const bool cv = kq.left >= 2;
        if (cv) { tr_item(C, kq.it, Ta); tr_item(C, kq.it + 1, Tb); tr_load(Ta, C.lane, cva); tr_load(Tb, C.lane, cvb); }
        for (int k = 2; k <= L; k <<= 1)
            for (int j = k >> 1; j > 0; j >>= 1) {
#pragma unroll
                for (int q = 0; q < 2; ++q) {
                    const int pp = C.tid + 512 * q, i = ((pp & ~(j - 1)) << 1) | (pp & (j - 1)), l = i | j;
                    const unsigned long long x = KY[i], y = KY[l]; const bool up = (i & k) == 0;
                    if ((x > y) == up) { KY[i] = y; KY[l] = x; }
                }
                __syncthreads();
            }
        if (cv) { tr_store(Ta, C.lane, cva); tr_store(Tb, C.lane, cvb); kq.it += 2; kq.left -= 2; }
        if (C.tid < CAP) { const unsigned long long key = ~KY[C.tid]; const int t = 2047 - (int)(unsigned)(key & 0xffffffffull); rk[t] = C.tid;
            if (half == 0) SELG[e * 2048 + b * 256 + C.tid] = __builtin_bit_cast(float, (unsigned)(key >> 32)); }
        __syncthreads();
        if (half == 0) for (int t = C.tid; t < L; t += NT) SLOT[((size_t)b * L + t) * 16 + e] = rk[t];
        for (int r0 = half * 128 + C.wave * 16; r0 < half * 128 + C.wave * 16 + 16; r0 += 4) {
            v4u x[4];
#pragma unroll
            for (int k = 0; k < 4; ++k) { const int t = 2047 - (int)(unsigned)((~KY[r0 + k]) & 0xffffffffull); x[k] = *((const v4u*)(HX2 + ((size_t)b * L + t) * D) + C.lane); }
#pragma unroll
            for (int k = 0; k < 4; ++k) *((v4u*)(XIN + ((size_t)e * 2048 + b * 256 + r0 + k) * D) + C.lane) = x[k];
        }
    }
    conv_flush(C, kq);
}

__device__ __forceinline__ void p10_row(const Ctx& C, int row, int sv, unsigned long long mask, const f32x4 (&xin)[4]) {
    const int lane = C.lane, b = row >> 11; const unsigned char* Y = (const unsigned char*)(C.ws + WS_YBUF);
    float* o = C.out + (size_t)row * D + 16 * lane;
    f32x4 acc[4] = {xin[0], xin[1], xin[2], xin[3]};
    while (mask) {
        int ee[4]; float wgt[4];
        const int e0 = __builtin_ctzll(mask);
#pragma unroll
        for (int k = 0; k < 4; ++k) { if (mask) { ee[k] = __builtin_ctzll(mask); mask &= mask - 1; wgt[k] = 1.f / 32.f; } else { ee[k] = e0; wgt[k] = 0.f; } }
        v4u y[4];
#pragma unroll
        for (int k = 0; k < 4; ++k) { const int sl = __builtin_amdgcn_readlane(sv, ee[k]); y[k] = *((const v4u*)(Y + ((size_t)ee[k] * 2048 + b * 256 + sl) * D) + lane); }
#pragma unroll
        for (int k = 0; k < 4; ++k) {
            const unsigned w[4] = {y[k].x, y[k].y, y[k].z, y[k].w};
#pragma unroll
            for (int q = 0; q < 4; ++q) { const f32x2_t lo = __builtin_amdgcn_cvt_pk_f32_fp8((int)w[q], false), hi = __builtin_amdgcn_cvt_pk_f32_fp8((int)w[q], true);
                acc[q][0] += wgt[k] * lo.x; acc[q][1] += wgt[k] * lo.y; acc[q][2] += wgt[k] * hi.x; acc[q][3] += wgt[k] * hi.y; }
        }
    }
#pragma unroll
    for (int q = 0; q < 4; ++q) *(f32x4*)(o + 4 * q) = acc[q];
}
__device__ __forceinline__ void p10_phase(const Ctx& C) {
    const int gw = C.bid * NWAVES + C.wave, NGW = C.nb * NWAVES, lane = C.lane;
    const int* SLOT = (const int*)(C.ws + WS_SLOT); const float* XN = (const float*)(C.ws + WS_XNEW);
    for (int row = gw * 2; row < M; row += NGW * 2) {
        const int sv0 = SLOT[(size_t)row * 16 + (lane & 15)], sv1 = SLOT[(size_t)(row + 1) * 16 + (lane & 15)];
        f32x4 x0[4], x1[4];
        { const float* xi = XN + (size_t)row * D + 16 * lane;
#pragma unroll
          for (int q = 0; q < 4; ++q) { x0[q] = *(const f32x4*)(xi + 4 * q); x1[q] = *(const f32x4*)(xi + D + 4 * q); } }
        const unsigned long long m0 = __ballot(sv0 >= 0) & 0xffffull, m1 = __ballot(sv1 >= 0) & 0xffffull;
        p10_row(C, row, sv0, m0, x0); p10_row(C, row + 1, sv1, m1, x1);
    }
}

__global__ void __launch_bounds__(NT, 2) mk_fwd(Args args) {
    extern __shared__ __attribute__((aligned(16))) unsigned char lds_raw[];
    Ctx C;
    C.lds = (LAS unsigned char*)lds_raw; C.tid = threadIdx.x; C.lane = C.tid & 63; C.wave = __builtin_amdgcn_readfirstlane(C.tid >> 6);
    C.bid = blockIdx.x; C.nb = gridDim.x; C.out = args.out; C.ws = args.ws; C.sub = args.sub;
#pragma unroll
    for (int i = 0; i < 30; ++i) C.in[i] = args.in[i];
    volatile LAS unsigned* MISC = (volatile LAS unsigned*)(C.lds + MISC_OFF);
    if (C.tid < 32) MISC[C.tid] = 0u;
    __syncthreads();
    unsigned* ctl = (unsigned*)(C.ws + WS_CTL);
    XcdBarrier bar; bar.bar = ctl + CW_BAR + args.li * XCD_BAR_WORDS; bar.x = 0; bar.st = nullptr;
    if (N_LAUNCHES != NPH) bar = xcd_barrier_post(ctl + CW_BAR + args.li * XCD_BAR_WORDS, MISC + 8);
    const int lo = args.ph_lo, hi = args.ph_hi;
#ifndef PH_MASK
#define PH_MASK 0xfff
#endif
#define IN(k) (((PH_MASK >> (k)) & 1) && lo <= (k) && (k) < hi)
#define SEAM(k) do { if (IN(k) && IN((k) + 1)) xcd_barrier(bar); } while (0)
    unsigned char* ws = C.ws;
    if (IN(0)) { p0_phase(C); } if (C.nb != 256) SEAM(0);
    if (IN(1)) { p1_phase(C); } SEAM(1);
    if (IN(2)) {
        pg8::SchedIn S{(const char*)(ws + WS_HX), (const char*)(ws + WS_WINT), C.nb, C.bid};
        pg8::Epi<EpiP2> E{{EpiZ{(bf16*)(ws + WS_ZT)}, EpiIn{(bf16*)(ws + WS_QRAW), (bf16*)(ws + WS_KRAW), (bf16*)(ws + WS_VB), (bf16*)(ws + WS_KC), (bf16*)(ws + WS_VC), (unsigned char*)(ws + WS_GA), (unsigned char*)(ws + WS_GB)}}};
        pg8::gemm_phase(C.lds, D, S, E);
        { pg8::SchedGate S8{(const char*)(ws + WS_HX8), (const char*)(ws + WS_WG8), C.nb, C.bid};
          pg8::gemm_phase<pg8::Epi<EpiP2>, pg8::SchedGate, true>(C.lds, D / 2, S8, E); }
        if (C.nb == 256 && C.bid >= 144) {
            TrItem Ta, Tb; f32x4 va[8], vb[8]; const int w0 = TR_NITEMS - TR_TAIL + ((C.bid - 144) * NWAVES + C.wave) * 4;
#pragma unroll 1
            for (int r = 0; r < 2; ++r) { tr_item(C, w0 + 2 * r, Ta); tr_item(C, w0 + 2 * r + 1, Tb); tr_load(Ta, C.lane, va); tr_load(Tb, C.lane, vb); tr_store(Ta, C.lane, va); tr_store(Tb, C.lane, vb); }
        }
    } SEAM(2);
    if (IN(3)) {
        if (C.nb == 256) { tap_table(C); asm volatile("s_waitcnt vmcnt(0)" ::: "memory"); __syncthreads(); }
        const bool attn_first = ((C.bid >> 3) & 1) != 0;
        if (attn_first) {
            if ((args.sub & 3) != 1) for (int it = C.bid; it < NB * 2 * 16; it += C.nb) attn_fast(C, it);
            __syncthreads();
            ConvSlice cq = conv_slice(C, TR_HY0, 16);
            if ((args.sub & 3) != 2) { hyena_zero_pads(C);
                for (int c = C.bid; c < HW; c += C.nb) hyena_fast(C, c, (c + C.nb < HW) ? c + C.nb : -1, cq); }
            conv_flush(C, cq);
        } else {
            ConvSlice cq = conv_slice(C, TR_HY0, 16);
            if ((args.sub & 3) != 2) { hyena_zero_pads(C);
                for (int c = C.bid; c < HW; c += C.nb) hyena_fast(C, c, (c + C.nb < HW) ? c + C.nb : -1, cq); }
            conv_flush(C, cq);
            __syncthreads();
            if ((args.sub & 3) != 1) for (int it = C.bid; it < NB * 2 * 16; it += C.nb) attn_fast(C, it);
        }
    } SEAM(3);
    if (IN(4)) { ya_transpose(C); } SEAM(4);
    if (IN(5)) {
        pg8::SchedP5 S{(const char*)(ws + WS_YA), (const char*)(ws + WS_WAT), (const char*)(ws + WS_YB), (const char*)(ws + WS_WBT), C.nb, C.bid};
        pg8::Epi<EpiP5> E{{EpiT1{(const unsigned char*)(ws + WS_GA), (bf16*)(ws + WS_TA)}, EpiT2{(const unsigned char*)(ws + WS_GB), (const bf16*)(ws + WS_TA), (bf16*)(ws + WS_MM)}}};
        pg8::gemm_phase(C.lds, HW, S, E);
    } SEAM(5);
    if (IN(6)) {
        pg8::SchedStd S{(const char*)(ws + WS_MM), (const char*)(ws + WS_WOUTT), D, 64, 4, C.nb, C.bid, 0};
        pg8::Epi<K0<EpiOut>> E{{EpiOut{C.in[IN_X], (const float*)(ws + WS_MOD), (float*)(ws + WS_XNEW)}}};
        pg8::gemm_phase(C.lds, D, S, E);
    } SEAM(6);
    if (IN(7)) { p6_phase(C); } SEAM(7);
    if (IN(8)) { p7_phase(C); } SEAM(8);
    if (IN(9)) {
        pg8::SchedStd S{(const char*)(ws + WS_XIN), (const char*)(ws + WS_W1T), D / 2, 128, 16, C.nb, C.bid, (size_t)4096 * D};
        pg8::Epi<K0<EpiH>> E{{EpiH{(unsigned char*)(ws + WS_HB)}}};
        pg8::gemm_phase<pg8::Epi<K0<EpiH>>, pg8::SchedStd, true>(C.lds, D / 2, S, E);
    } SEAM(9);
    if (IN(10)) {
        pg8::SchedStd S{(const char*)(ws + WS_HB), (const char*)(ws + WS_W2T), DFF / 2, 128, 4, C.nb, C.bid, (size_t)1024 * DFF};
        pg8::Epi<K0<EpiY>> E{{EpiY{(const float*)(ws + WS_SELG), (const float*)(ws + WS_MOD), (unsigned char*)(ws + WS_YBUF)}}};
        pg8::gemm_phase<pg8::Epi<K0<EpiY>>, pg8::SchedStd, true>(C.lds, DFF / 2, S, E);
    } SEAM(10);
    if (IN(11)) { p10_phase(C); }
#undef IN
#undef SEAM
}

extern "C" void kernel_launch(void* const* d_in, const int* in_sizes, int n_in, void* d_out, int out_size, void* d_ws, size_t ws_size, hipStream_t stream) {
    static int grid = 0;
    if (grid == 0) {
        if (n_in != 30 || in_sizes[0] != M * D || out_size != M * D || ws_size < WS_END) { fprintf(stderr, "kernel_launch: unexpected shapes: n_in %d in0 %d out %d ws %zu (need %zu)\n", n_in, n_in > 0 ? in_sizes[0] : -1, out_size, ws_size, (size_t)WS_END); grid = -1; return; }
        int dev = 0, cus = 0, per_cu = 0;
        if (hipGetDevice(&dev) != hipSuccess || hipDeviceGetAttribute(&cus, hipDeviceAttributeMultiprocessorCount, dev) != hipSuccess) { grid = -1; return; }
        if (hipFuncSetAttribute((const void*)mk_fwd, hipFuncAttributeMaxDynamicSharedMemorySize, LDS_BYTES) != hipSuccess) { fprintf(stderr, "kernel_launch: hipFuncSetAttribute failed\n"); grid = -1; return; }
        if (hipOccupancyMaxActiveBlocksPerMultiprocessor(&per_cu, (const void*)mk_fwd, NT, LDS_BYTES) != hipSuccess || per_cu < 1) { fprintf(stderr, "kernel_launch: occupancy query says %d\n", per_cu); per_cu = 1; }
        (void)hipGetLastError();
        grid = cus;
    }
    if (grid < 0) return;
    if (hipMemsetAsync((char*)d_ws + WS_CTL, 0, CTL_ZERO_BYTES, stream) != hipSuccess) { fprintf(stderr, "kernel_launch: memset failed\n"); return; }
    Args a{};
    for (int i = 0; i < 30; ++i) a.in[i] = (const float*)d_in[i];
    a.out = (float*)d_out; a.ws = (unsigned char*)d_ws;
    if (N_LAUNCHES == NPH) {
        for (int li = 0; li < NPH; ++li) { a.ph_lo = li; a.ph_hi = li + 1; a.li = 0;
            for (int rep = 0; rep < (((DUP_MASK >> li) & 1) ? 2 : 1); ++rep) { a.sub = (rep == 0 && ((DUP_MASK >> li) & 1)) ? DUP_SUB : 0; hipLaunchKernelGGL(mk_fwd, dim3(grid), dim3(NT), LDS_BYTES, stream, a); } }
    } else {
        a.ph_lo = 0; a.ph_hi = NPH; a.li = 0;
        hipLaunchKernelGGL(mk_fwd, dim3(grid), dim3(NT), LDS_BYTES, stream, a);
    }
}
```

```cpp
#include <hip/hip_runtime.h>
#include <cstdio>
#include <cstdint>

#define GAS __attribute__((address_space(1)))
#define LAS __attribute__((address_space(3)))
typedef unsigned short bf16;
typedef unsigned v4u __attribute__((ext_vector_type(4)));
typedef unsigned v2u __attribute__((ext_vector_type(2)));
typedef float f32x4 __attribute__((ext_vector_type(4)));
typedef short bf16x8 __attribute__((ext_vector_type(8)));

#ifndef DUP_MASK
#define DUP_MASK 0
#endif
#ifndef DUP_SUB
#define DUP_SUB 0
#endif
#ifndef MK_N_LAUNCHES
#define MK_N_LAUNCHES 1
#endif
constexpr int NPH = 12;
constexpr int N_LAUNCHES = MK_N_LAUNCHES;
constexpr int NWAVES = 8, NT = NWAVES * 64;

constexpr int D = 1024, NB = 8, L = 2048, LC = 256, M = NB * L, MC = NB * LC, MT = M + MC;
constexpr int HW = 512, QW = 512, KVW = 128, NE = 16, CAP = 256, DFF = 2048, INW = 4352;
constexpr int OFF_Q = 1536, OFF_K = 2048, OFF_V = 2176, OFF_G = 2304;
constexpr int MODW = 6 * D;
constexpr float EPS = 1e-6f;
constexpr int GT_LEN = 4096;

constexpr size_t MiB = 1u << 20;
constexpr size_t WS_CTL = 0, CTL_ZERO_BYTES = 64 * 1024;
constexpr size_t WS_MOD = 1 * MiB;
constexpr size_t WS_H3 = 1 * MiB + 512 * 1024;
constexpr size_t WS_ROPE = 2 * MiB;
constexpr size_t WS_AFF = 3 * MiB;
constexpr size_t WS_SLOT = 4 * MiB;
constexpr size_t WS_SELG = 5 * MiB;
constexpr size_t WS_GTAB = 6 * MiB;
constexpr size_t WS_WINT = 14 * MiB;
constexpr size_t WS_WAT = 23 * MiB;
constexpr size_t WS_WBT = 24 * MiB;
constexpr size_t WS_WOUTT = 25 * MiB;
constexpr size_t WS_W1T = 28 * MiB;
constexpr size_t WS_HX8 = 92 * MiB;
constexpr size_t WS_WG8 = 108 * MiB;
constexpr size_t WS_UPART = 112 * MiB;
constexpr size_t WS_SSQP = 116 * MiB;
constexpr size_t WS_GRT = 117 * MiB;
constexpr size_t WS_CB = 118 * MiB;
constexpr size_t WS_W2T = 156 * MiB;
constexpr size_t WS_R1 = 220 * MiB;
constexpr size_t WS_HX = WS_R1;
constexpr size_t WS_ZT = WS_R1 + 36 * MiB;
constexpr size_t WS_QRAW = WS_R1 + 84 * MiB;
constexpr size_t WS_KRAW = WS_R1 + 100 * MiB;
constexpr size_t WS_VB = WS_R1 + 104 * MiB;
constexpr size_t WS_KC = WS_R1 + 108 * MiB;
constexpr size_t WS_VC = WS_R1 + 108 * MiB + 512 * 1024;
constexpr size_t WS_YAT = WS_R1 + 110 * MiB;
constexpr size_t WS_TA = WS_R1;
constexpr size_t WS_MM = WS_R1 + 32 * MiB;
constexpr size_t WS_HB = WS_R1;
constexpr size_t WS_R2 = 348 * MiB;
constexpr size_t WS_GA = WS_R2, WS_GB = WS_R2 + 32 * MiB;
constexpr size_t WS_XIN = WS_R2;
constexpr size_t WS_YBUF = WS_R2;
constexpr size_t WS_R3 = 412 * MiB;
constexpr size_t WS_YA = WS_R3, WS_YB = WS_R3 + 16 * MiB;
constexpr size_t WS_HX2 = WS_R3;
constexpr size_t WS_XNEW = 444 * MiB;
constexpr size_t WS_END = 508 * MiB;

constexpr int CW_BAR = 4096;
constexpr int LDS_BYTES = 147456;
constexpr int MISC_OFF = 147456 - 256;

__device__ __forceinline__ unsigned f2bf(float f) { unsigned u = __builtin_bit_cast(unsigned, f); return (u + 0x7fffu + ((u >> 16) & 1u)) >> 16; }
typedef float f32x2_t __attribute__((ext_vector_type(2)));
typedef __bf16 bf16x2_t __attribute__((ext_vector_type(2)));
__device__ __forceinline__ unsigned cvtpk(float lo, float hi) { f32x2_t v = {lo, hi}; bf16x2_t b = __builtin_convertvector(v, bf16x2_t); return __builtin_bit_cast(unsigned, b); }
__device__ __forceinline__ unsigned pk2(float lo, float hi) { return cvtpk(lo, hi); }
__device__ __forceinline__ unsigned pk4_fp8(float a, float b, float c, float d) { int w = 0; w = __builtin_amdgcn_cvt_pk_fp8_f32(a, b, w, false); w = __builtin_amdgcn_cvt_pk_fp8_f32(c, d, w, true); return (unsigned)w; }
__device__ __forceinline__ float bf2f(unsigned b) { return __builtin_bit_cast(float, b << 16); }
__device__ __forceinline__ float bflo(unsigned w) { return __builtin_bit_cast(float, w << 16); }
__device__ __forceinline__ float bfhi(unsigned w) { return __builtin_bit_cast(float, w & 0xffff0000u); }
__device__ __forceinline__ float rbf(float f) { return bf2f(f2bf(f)); }
__device__ __forceinline__ void unpack8_u8(v2u w, float* o) {
    const float k = 1.f / 255.f;
    o[0] = (float)(w.x & 255u) * k; o[1] = (float)((w.x >> 8) & 255u) * k; o[2] = (float)((w.x >> 16) & 255u) * k; o[3] = (float)(w.x >> 24) * k;
    o[4] = (float)(w.y & 255u) * k; o[5] = (float)((w.y >> 8) & 255u) * k; o[6] = (float)((w.y >> 16) & 255u) * k; o[7] = (float)(w.y >> 24) * k; }
__device__ __forceinline__ void unpack8(v4u w, float* o) { o[0] = bflo(w.x); o[1] = bfhi(w.x); o[2] = bflo(w.y); o[3] = bfhi(w.y); o[4] = bflo(w.z); o[5] = bfhi(w.z); o[6] = bflo(w.w); o[7] = bfhi(w.w); }
__device__ __forceinline__ v4u pack8(const float* v) { v4u w; w.x = pk2(v[0], v[1]); w.y = pk2(v[2], v[3]); w.z = pk2(v[4], v[5]); w.w = pk2(v[6], v[7]); return w; }
__device__ __forceinline__ float siluf(float x) { return x * __builtin_amdgcn_rcpf(1.f + __expf(-x)); }
__device__ __forceinline__ float sigmf(float x) { return __builtin_amdgcn_rcpf(1.f + __expf(-x)); }
__device__ __forceinline__ float wave_sum(float v) {
#pragma unroll
    for (int o = 1; o < 64; o <<= 1) v += __shfl_xor(v, o);
    return v;
}
#define LDS_WAIT() asm volatile("s_waitcnt lgkmcnt(0)" ::: "memory")
#define LDS_BARRIER() do { asm volatile("s_waitcnt lgkmcnt(0)" ::: "memory"); __builtin_amdgcn_s_barrier(); asm volatile("" ::: "memory"); } while (0)

#define XB_TMO      128
#define XB_XCNT(j)  (256  + 64 * (j))
#define XB_XSUB(j)  (1280 + 64 * (j))
#define XB_XGEN(j)  (2304 + 64 * (j))
#define XB_TOP      3328
#define XB_TOPGEN   3392
#define XCD_BAR_WORDS 3456
#define XB_SPIN_CAP (1u << 25)
__device__ __forceinline__ unsigned xb_ld(unsigned* p)              { return __hip_atomic_load(p, __ATOMIC_RELAXED, __HIP_MEMORY_SCOPE_AGENT); }
__device__ __forceinline__ unsigned xb_add(unsigned* p, unsigned v) { return __hip_atomic_fetch_add(p, v, __ATOMIC_RELAXED, __HIP_MEMORY_SCOPE_AGENT); }
__device__ __forceinline__ unsigned xb_xcc_id() { return (unsigned)__builtin_amdgcn_s_getreg((3 << 11) | 20) & 0xFu; }
#define XB_SPIN(cond, bar) do { unsigned _sp = 0; while (cond) { __builtin_amdgcn_s_sleep(1); \
    if ((++_sp & 255u) == 0u) { if (xb_ld(&(bar)[XB_TMO])) break; if (_sp > XB_SPIN_CAP) { atomicAdd(&(bar)[XB_TMO], 1u); break; } } } } while (0)
struct XcdBarrier { unsigned* bar; unsigned x; volatile LAS unsigned* st; };
__device__ __forceinline__ XcdBarrier xcd_barrier_post(unsigned* bar, volatile LAS unsigned* st) {
    XcdBarrier b; b.bar = bar; b.x = xb_xcc_id(); b.st = st;
    if (threadIdx.x == 0) (void)xb_add(&bar[XB_XCNT(b.x)], 1u);
    return b;
}
__device__ __forceinline__ void xcd_barrier_complete(unsigned* bar, unsigned x, unsigned& nloc, unsigned& nx) {
    const unsigned G = gridDim.x * gridDim.y * gridDim.z;
    unsigned sum, cnt, mine, sp = 0u;
    for (;;) {
        sum = 0u; cnt = 0u; mine = 0u;
#pragma unroll
        for (unsigned j = 0; j < 16; ++j) { const unsigned c = xb_ld(&bar[XB_XCNT(j)]); sum += c; cnt += (c > 0u) ? 1u : 0u; mine = (j == x) ? c : mine; }
        if (sum == G) break;
        __builtin_amdgcn_s_sleep(1);
        if ((++sp & 255u) == 0u) { if (xb_ld(&bar[XB_TMO])) break; if (sp > XB_SPIN_CAP) { atomicAdd(&bar[XB_TMO], 1u); break; } }
    }
    nloc = mine > 0u ? mine : 1u; nx = cnt > 0u ? cnt : 1u;
}
__device__ __forceinline__ void xcd_barrier(const XcdBarrier& b) {
    asm volatile("s_waitcnt vmcnt(0)" ::: "memory");
    __syncthreads();
    if (threadIdx.x == 0) {
        unsigned* bar = b.bar;
        __builtin_amdgcn_s_waitcnt(0);
        unsigned nloc = b.st[0], nx = b.st[1];
        if (nloc == 0u) { xcd_barrier_complete(bar, b.x, nloc, nx); b.st[0] = nloc; b.st[1] = nx; }
        const unsigned old = xb_add(&bar[XB_XSUB(b.x)], 1u);
        const unsigned gen = old / nloc;
        if (old + 1u == (gen + 1u) * nloc) {
            __builtin_amdgcn_fence(__ATOMIC_RELEASE, "agent");
            asm volatile("s_waitcnt vmcnt(0)" ::: "memory");
            const unsigned og = xb_add(&bar[XB_TOP], 1u);
            const unsigned tg = og / nx;
            if (og + 1u == (tg + 1u) * nx) xb_add(&bar[XB_TOPGEN], 1u);
            else XB_SPIN(xb_ld(&bar[XB_TOPGEN]) == tg, bar);
            __builtin_amdgcn_fence(__ATOMIC_ACQUIRE, "agent");
            xb_add(&bar[XB_XGEN(b.x)], 1u);
            asm volatile("s_waitcnt vmcnt(0)" ::: "memory");
        } else {
            XB_SPIN(xb_ld(&bar[XB_XGEN(b.x)]) == gen, bar);
            __builtin_amdgcn_fence(__ATOMIC_ACQUIRE, "agent");
            asm volatile("s_waitcnt vmcnt(0)" ::: "memory");
        }
    }
    __syncthreads();
}

constexpr int CW_SB0 = 2048;
__device__ __forceinline__ void sb_arrive(unsigned* cnt) {
    asm volatile("s_waitcnt vmcnt(0)" ::: "memory");
    __syncthreads();
    if (threadIdx.x == 0) { __builtin_amdgcn_fence(__ATOMIC_RELEASE, "agent"); asm volatile("s_waitcnt vmcnt(0)" ::: "memory"); (void)xb_add(cnt, 1u); }
}
__device__ __forceinline__ void sb_wait(unsigned* cnt, unsigned target, unsigned* tmo) {
    if (threadIdx.x == 0) {
        unsigned sp = 0u;
        while (xb_ld(cnt) < target) { __builtin_amdgcn_s_sleep(1); if ((++sp & 255u) == 0u) { if (xb_ld(tmo)) break; if (sp > XB_SPIN_CAP) { atomicAdd(tmo, 1u); break; } } }
        __builtin_amdgcn_fence(__ATOMIC_ACQUIRE, "agent"); asm volatile("s_waitcnt vmcnt(0)" ::: "memory");
    }
    __syncthreads();
}

struct Args { const float* in[30]; float* out; unsigned char* ws; int ph_lo, ph_hi, li, sub; };
struct Ctx {
    LAS unsigned char* lds; int tid, lane, wave, bid, nb, sub;
    const float* in[30]; float* out; unsigned char* ws;
};
#define IN_X 0
#define IN_C 1
#define IN_CTX 2
#define IN_CCTX 3
#define IN_ADAW 4
#define IN_ADAB 5
#define IN_NORM1 6
#define IN_NORM2 7
#define IN_WIN 8
#define IN_CONVW 9
#define IN_CONVB 10
#define IN_FW1 11
#define IN_FB1 12
#define IN_FW2 13
#define IN_FB2 14
#define IN_FW3 15
#define IN_FB3 16
#define IN_FFREQ 17
#define IN_FOUT 18
#define IN_HBIAS 19
#define IN_QNORM 20
#define IN_KNORM 21
#define IN_SINK 22
#define IN_WA 23
#define IN_WB 24
#define IN_WOUT 25
#define IN_ROUTER 26
#define IN_WGATE 27
#define IN_WUP 28
#define IN_WDOWN 29

template <class Epi, class Units>
__device__ __forceinline__ void gemm_naive(const Ctx& C, int K, int lda, int ldb, const Units& U, const Epi& E) {
    LAS float* As = (LAS float*)C.lds;
    LAS float* Bs = As + 32 * 132;
    const int tid = C.tid, ty = tid >> 4, tx = tid & 15;
    for (int idx = C.bid;; idx += C.nb) {
        int pm, pn; const bf16* Ab; const bf16* Bb;
        if (!U.get(idx, pm, pn, Ab, Bb)) break;
        for (int half = 0; half < 2; ++half) {
            float acc[4][16];
#pragma unroll
            for (int r = 0; r < 4; ++r)
#pragma unroll
                for (int j = 0; j < 16; ++j) acc[r][j] = 0.f;
            for (int k0 = 0; k0 < K; k0 += 32) {
                {
                    const int row = tid >> 2, kc = tid & 3;
                    const v4u w = *(const v4u*)(Ab + (size_t)(half * 128 + row) * lda + k0 + kc * 8);
                    float f[8]; unpack8(w, f);
#pragma unroll
                    for (int j = 0; j < 8; ++j) As[(kc * 8 + j) * 132 + row] = f[j];
                }
#pragma unroll
                for (int i = 0; i < 2; ++i) {
                    const int c = tid + 512 * i, row = c >> 2, kc = c & 3;
                    const v4u w = *(const v4u*)(Bb + (size_t)row * ldb + k0 + kc * 8);
                    float f[8]; unpack8(w, f);
#pragma unroll
                    for (int j = 0; j < 8; ++j) Bs[(kc * 8 + j) * 260 + row] = f[j];
                }
                __syncthreads();
#pragma unroll 4
                for (int k = 0; k < 32; ++k) {
                    const f32x4 a = *(const LAS f32x4*)(As + k * 132 + ty * 4);
                    const f32x4 b0 = *(const LAS f32x4*)(Bs + k * 260 + tx * 8), b1 = *(const LAS f32x4*)(Bs + k * 260 + tx * 8 + 4);
                    const f32x4 b2 = *(const LAS f32x4*)(Bs + k * 260 + 128 + tx * 8), b3 = *(const LAS f32x4*)(Bs + k * 260 + 128 + tx * 8 + 4);
#pragma unroll
                    for (int r = 0; r < 4; ++r) {
#pragma unroll
                        for (int j = 0; j < 4; ++j) { acc[r][j] += a[r] * b0[j]; acc[r][4 + j] += a[r] * b1[j]; acc[r][8 + j] += a[r] * b2[j]; acc[r][12 + j] += a[r] * b3[j]; }
                    }
                }
                __syncthreads();
            }
#pragma unroll
            for (int r = 0; r < 4; ++r) E(pm * 256 + half * 128 + ty * 4 + r, pn, tx * 8, &acc[r][0], &acc[r][8]);
        }
    }
}


namespace pg8 {
constexpr int BM = 256, BK = 64, HALF = 128, HTB = HALF * BK * 2, NXCD = 8, WGM = 8;
__device__ __forceinline__ int lds_byte(int r, int c) { const int st = (r >> 4) * 2 + (c >> 5), rr = r & 15, cc = c & 31, ob = rr * 64 + cc * 2; return st * 1024 + (ob ^ (((ob >> 9) & 1) << 5)); }
__device__ __forceinline__ void stage_rc(int b, int& R, int& C) { const int st = b / 1024, sb = b % 1024, swz = sb ^ (((sb >> 9) & 1) << 5); R = (st >> 1) * 16 + swz / 64; C = (st & 1) * 32 + (swz % 64) / 2; }
__device__ __forceinline__ int perm32(int rho) { const int n = rho >> 4, i = rho & 15; return 8 * (i >> 2) + 4 * n + (i & 3); }
struct Unit { int pm, pn, kind; const char* A; const char* B; };
__device__ __forceinline__ void tile_of(int w, int nM, int nN, int& pm, int& pn) {
    const int nwg = nM * nN; int wgid = w; { const int q = nwg / NXCD, r = nwg % NXCD, xcd = wgid % NXCD, off = wgid / NXCD; wgid = (xcd < r ? xcd * (q + 1) : r * (q + 1) + (xcd - r) * q) + off; }
    const int nig = WGM * nN, gid = wgid / nig, fm = gid * WGM, gsz = (nM - fm) < WGM ? (nM - fm) : WGM;
    pm = fm + ((wgid % nig) % gsz); pn = (wgid % nig) / gsz;
}
template <class F> struct Epi {
    F f;
    __device__ __forceinline__ bool carry(const Unit&) const { return false; }
    __device__ __forceinline__ void operator()(const f32x4 (&acc)[2][2][4][2], const Unit& u, int wr, int wc, int fr, int fq) const {
#pragma unroll
        for (int ai = 0; ai < 2; ++ai)
#pragma unroll
            for (int m = 0; m < 4; ++m) {
                float v0[8], v1[8];
#pragma unroll
                for (int n = 0; n < 2; ++n)
#pragma unroll
                    for (int i = 0; i < 4; ++i) { v0[4 * n + i] = acc[ai][0][m][n][i]; v1[4 * n + i] = acc[ai][1][m][n][i]; }
                f(u.kind, u.pm * BM + ai * HALF + wr * 64 + m * 16 + fr, u.pn, wc * 32 + 8 * fq, v0, v1);
            }
    }
};
template <class EpiT, class Sched, bool FP8 = false, bool AFTER_DRAIN = false, bool PF = false, int CONT = 0, bool AKM = false>
__device__ __forceinline__ void gemm_phase_acc(LAS unsigned char* lds, const int K, const Sched& S, const EpiT& E, f32x4 (&acc)[2][2][4][2], const Unit* contU = nullptr, const int contK = 0, const size_t akm_pitch = 0) {
    const int tid = threadIdx.x, wid = __builtin_amdgcn_readfirstlane(tid >> 6), lane = tid & 63, wr = wid >> 2, wc = wid & 3, fr = lane & 15, fq = lane >> 4;
    const int nt = K / BK;
    unsigned voffA[2], voffB[2];
#pragma unroll
    for (int i = 0; i < 2; ++i) { int R, C; stage_rc(tid * 16 + i * 8192, R, C); const int Rb = (R & ~31) + perm32(R & 31);
        voffA[i] = (unsigned)(R * K + C) * 2u; voffB[i] = (unsigned)(Rb * K + C) * 2u; }
    const size_t kstep = (size_t)(BK * 2);
    const size_t hstep = (size_t)HALF * K * 2;
    size_t kstepA = kstep, hstepA = hstep;
    unsigned akp[4] = {0u, 0u, 0u, 0u}; unsigned akb = 0u;
    if constexpr (AKM) {
#pragma unroll
        for (int i = 0; i < 2; ++i) { const unsigned p = (unsigned)tid * 16u + (unsigned)i * 8192u, ch = p >> 8, js = (p >> 4) & 15u; voffA[i] = ch * (unsigned)akm_pitch + ((js ^ (2u * (ch & 7u))) << 4); }
        kstepA = (size_t)BK * akm_pitch; hstepA = (size_t)HALF * 2;
        const unsigned qp = (unsigned)(fr >> 2), pp = (unsigned)(fr & 3);
        akb = (8u * (unsigned)fq + qp) * 256u + (pp & 1u) * 8u;
#pragma unroll
        for (int m = 0; m < 4; ++m) akp[m] = (((2u * (unsigned)(wr * 4 + m)) + (pp >> 1)) ^ (2u * qp)) << 4;
    }
    unsigned voffAc[2] = {0u, 0u}, voffBc[2] = {0u, 0u}; size_t hstepc = 0;
    if constexpr (CONT == 1) {
#pragma unroll
        for (int i = 0; i < 2; ++i) { int R, C; stage_rc(tid * 16 + i * 8192, R, C); const int Rb = (R & ~31) + perm32(R & 31);
            voffAc[i] = (unsigned)(R * contK + C) * 2u; voffBc[i] = (unsigned)(Rb * contK + C) * 2u; }
        hstepc = (size_t)HALF * contK * 2;
    }
    const unsigned ldsw = (unsigned)wid * 1024u;
    const int aoff = lds_byte(wr * 64 + fr, fq * 8), boff = lds_byte(wc * 32 + fr, fq * 8);
#define PG8_SA(b, h) (((b) * 2 + (h)) * HTB)
#define PG8_SB(b, h) ((4 + (b) * 2 + (h)) * HTB)
#define PG8_STAGE(bufoff, gbase, voff) do { _Pragma("unroll") for (int _i = 0; _i < 2; ++_i) \
        __builtin_amdgcn_global_load_lds((const unsigned*)((const char*)(gbase) + (voff)[_i]), (LAS unsigned*)(lds + (bufoff) + ldsw + _i * 8192), 16, 0, 0); } while (0)
#define PG8_LDA(dst, b, h) do { _Pragma("unroll") for (int m = 0; m < 4; ++m) { if constexpr (AKM) { _Pragma("unroll") for (int k = 0; k < 2; ++k) { \
        const v4s_ lo_ = __builtin_amdgcn_ds_read_tr16_b64_v4i16((LAS v4s_*)(lds + PG8_SA(b, h) + k * 8192 + akb + akp[m])), \
                   hi_ = __builtin_amdgcn_ds_read_tr16_b64_v4i16((LAS v4s_*)(lds + PG8_SA(b, h) + k * 8192 + akb + 1024 + (akp[m] ^ 128u))); \
        dst[m][k] = __builtin_shufflevector(lo_, hi_, 0, 1, 2, 3, 4, 5, 6, 7); } } else if constexpr (FP8) { \
        dst##8[m] = __builtin_shufflevector(*(const LAS v4i_*)(lds + PG8_SA(b, h) + aoff + m * 2048), *(const LAS v4i_*)(lds + PG8_SA(b, h) + aoff + m * 2048 + 1024), 0, 1, 2, 3, 4, 5, 6, 7); } \
        else { _Pragma("unroll") for (int k = 0; k < 2; ++k) dst[m][k] = *(const LAS bf16x8*)(lds + PG8_SA(b, h) + aoff + m * 2048 + k * 1024); } } } while (0)
#define PG8_LDB(dst, b, h) do { _Pragma("unroll") for (int n = 0; n < 2; ++n) { if constexpr (FP8) { \
        dst##8[n] = __builtin_shufflevector(*(const LAS v4i_*)(lds + PG8_SB(b, h) + boff + n * 2048), *(const LAS v4i_*)(lds + PG8_SB(b, h) + boff + n * 2048 + 1024), 0, 1, 2, 3, 4, 5, 6, 7); } \
        else { _Pragma("unroll") for (int k = 0; k < 2; ++k) dst[n][k] = *(const LAS bf16x8*)(lds + PG8_SB(b, h) + boff + n * 2048 + k * 1024); } } } while (0)
#define PG8_MMA(ai, bj, At, Bt) do { __builtin_amdgcn_s_setprio(1); _Pragma("unroll") for (int m = 0; m < 4; ++m) _Pragma("unroll") for (int n = 0; n < 2; ++n) { \
        if constexpr (FP8) asm volatile("v_mfma_scale_f32_16x16x128_f8f6f4 %0, %1, %2, %0, %3, %4 op_sel_hi:[0,0,0]" : "+v"(acc[ai][bj][m][n]) : "v"(Bt##8[n]), "v"(At##8[m]), "v"(sc_w), "v"(sc_x)); \
        else { _Pragma("unroll") for (int k = 0; k < 2; ++k) acc[ai][bj][m][n] = __builtin_amdgcn_mfma_f32_16x16x32_bf16(Bt[n][k], At[m][k], acc[ai][bj][m][n], 0, 0, 0); } } \
        __builtin_amdgcn_s_setprio(0); } while (0)
#define PG8_WAIT_V(n) asm volatile("s_waitcnt vmcnt(" #n ")" ::: "memory")
#define PG8_WAIT_L(n) asm volatile("s_waitcnt lgkmcnt(" #n ")" ::: "memory")
#define PG8_BAR __builtin_amdgcn_s_barrier()
#define PG8_SCHED __builtin_amdgcn_sched_barrier(0)
    Unit cur, nxt; int ui = 0;
    if (!S.next(0, cur)) return;
    if constexpr (CONT != 2) {
#pragma unroll
    for (int a = 0; a < 2; ++a)
#pragma unroll
        for (int b = 0; b < 2; ++b)
#pragma unroll
            for (int m = 0; m < 4; ++m)
#pragma unroll
                for (int n = 0; n < 2; ++n) acc[a][b][m][n] = (f32x4){0.f, 0.f, 0.f, 0.f};
    }
    typedef short v4s_ __attribute__((ext_vector_type(4)));
    typedef int v4i_ __attribute__((ext_vector_type(4))); typedef int v8i_ __attribute__((ext_vector_type(8)));
    const int sc_w = 0x7a7a7a7a, sc_x = 0x7f7f7f7f;
    bf16x8 At[4][2], B0[2][2], B1[2][2]; v8i_ At8[4], B08[2], B18[2];
    const char* cA = cur.A; const char* cB = cur.B;
    if constexpr (CONT != 2) {
    PG8_STAGE(PG8_SB(0, 0), cB, voffB); PG8_STAGE(PG8_SB(0, 1), cB + hstep, voffB); PG8_STAGE(PG8_SA(0, 0), cA, voffA); PG8_STAGE(PG8_SA(0, 1), cA + hstepA, voffA);
    if (wr == 1) PG8_BAR;
    PG8_WAIT_V(2); PG8_BAR;
    PG8_STAGE(PG8_SB(1, 0), cB + kstep, voffB); PG8_STAGE(PG8_SA(1, 0), cA + kstepA, voffA); PG8_STAGE(PG8_SB(1, 1), cB + hstep + kstep, voffB);
    PG8_WAIT_V(6); PG8_BAR;
    }
    for (;;) {
        const bool has_next = S.next(ui + 1, nxt);
        const char* nA = has_next ? nxt.A : (CONT == 1 ? contU->A : cA); const char* nB = has_next ? nxt.B : (CONT == 1 ? contU->B : cB);
        for (int t = 0; t < nt; t += 2) {
            const bool last = (t == nt - 2);
            const bool lc = (CONT == 1) && last && !has_next;
            const char* a1 = cA + (size_t)(t + 1) * kstepA;
            const char* a2 = last ? nA : cA + (size_t)(t + 2) * kstepA; const char* b2 = last ? nB : cB + (size_t)(t + 2) * kstep;
            const char* a3 = a2 + (lc ? kstep : kstepA); const char* b3 = b2 + kstep;
            const unsigned vA[2] = {lc ? voffAc[0] : voffA[0], lc ? voffAc[1] : voffA[1]}, vB[2] = {lc ? voffBc[0] : voffB[0], lc ? voffBc[1] : voffB[1]};
            const size_t hsA = lc ? hstepc : hstepA, hsB = lc ? hstepc : hstep;
            PG8_LDB(B0, 0, 0); PG8_LDB(B1, 0, 1); PG8_SCHED; PG8_LDA(At, 0, 0); PG8_STAGE(PG8_SA(1, 1), a1 + hstepA, voffA);
            PG8_WAIT_V(8); PG8_WAIT_L(0); PG8_BAR; PG8_MMA(0, 0, At, B0); PG8_MMA(0, 1, At, B1); PG8_BAR; PG8_SCHED;
            PG8_LDA(At, 0, 1); PG8_STAGE(PG8_SB(0, 0), b2, vB); PG8_STAGE(PG8_SB(0, 1), b2 + hsB, vB); PG8_STAGE(PG8_SA(0, 0), a2, vA);
            PG8_WAIT_V(8); PG8_WAIT_L(0); PG8_BAR; PG8_MMA(1, 0, At, B0); PG8_MMA(1, 1, At, B1); PG8_BAR; PG8_SCHED;
            PG8_LDB(B0, 1, 0); PG8_LDB(B1, 1, 1); PG8_SCHED; PG8_LDA(At, 1, 0); PG8_STAGE(PG8_SA(0, 1), a2 + hsA, vA);
            PG8_WAIT_V(8); PG8_WAIT_L(0); PG8_BAR; PG8_MMA(0, 0, At, B0); PG8_MMA(0, 1, At, B1); PG8_BAR; PG8_SCHED;
            PG8_LDA(At, 1, 1); PG8_STAGE(PG8_SB(1, 0), b3, vB); PG8_STAGE(PG8_SB(1, 1), b3 + hsB, vB); PG8_STAGE(PG8_SA(1, 0), a3, vA);
            PG8_WAIT_V(8); PG8_WAIT_L(0); PG8_BAR; PG8_MMA(1, 0, At, B0); PG8_MMA(1, 1, At, B1); PG8_BAR; PG8_SCHED;
        }
        if (wr == 0) PG8_BAR;
        if constexpr (PF) if (has_next && wid < 4) {
            const size_t o = ((size_t)(((nxt.pm & 7) * 4 + wid) * 64 + lane)) * 128;
            __builtin_amdgcn_global_load_lds((const unsigned*)(nB + o), (LAS unsigned*)(lds + 8 * HTB + wid * 256), 4, 0, 0);
        }
        if constexpr (FP8) asm volatile("s_nop 15\n\ts_nop 15" ::: "memory");
        if constexpr (!AFTER_DRAIN) E(acc, cur, wr, wc, fr, fq);
        if (!has_next) { if constexpr (CONT == 1) { if (wr == 1) PG8_BAR; } break; }
        if (!E.carry(cur)) {
#pragma unroll
        for (int a = 0; a < 2; ++a)
#pragma unroll
            for (int b = 0; b < 2; ++b)
#pragma unroll
                for (int m = 0; m < 4; ++m)
#pragma unroll
                    for (int n = 0; n < 2; ++n) acc[a][b][m][n] = (f32x4){0.f, 0.f, 0.f, 0.f};
        }
        cur = nxt; cA = nA; cB = nB; ++ui;
        if (wr == 1) PG8_BAR;
    }
    if constexpr (CONT != 1) { PG8_WAIT_V(0); PG8_BAR; }
    if constexpr (AFTER_DRAIN) E.fused(acc, cur, wr, wc, fr, fq, lds);
#undef PG8_SA
#undef PG8_SB
#undef PG8_STAGE
#undef PG8_LDA
#undef PG8_LDB
#undef PG8_MMA
#undef PG8_WAIT_V
#undef PG8_WAIT_L
#undef PG8_BAR
#undef PG8_SCHED
}
template <class EpiT, class Sched, bool FP8 = false, bool AFTER_DRAIN = false, bool PF = false>
__device__ __forceinline__ void gemm_phase(LAS unsigned char* lds, const int K, const Sched& S, const EpiT& E) {
    f32x4 acc[2][2][4][2];
    gemm_phase_acc<EpiT, Sched, FP8, AFTER_DRAIN, PF, 0, false>(lds, K, S, E, acc);
}
struct SchedStd {
    const char* A; const char* Bt; int K, nM, nN, G, c; size_t bgroup;
    __device__ __forceinline__ bool next(int i, Unit& u) const {
        const long Lid = (long)i * G + c; if (Lid >= (long)nM * nN) return false;
        tile_of((int)Lid, nM, nN, u.pm, u.pn); u.kind = 0;
        u.A = A + (size_t)u.pm * 256 * K * 2; u.B = Bt + (size_t)(u.pm >> 3) * bgroup + (size_t)u.pn * 256 * K * 2; return true;
    }
};
struct SchedIn {
    const char* HX; const char* WINT; int G, c;
    __device__ __forceinline__ bool next(int i, Unit& u) const {
        const long Lid = (long)i * G + c;
        if (Lid < 384) { tile_of((int)Lid, 6, 64, u.pm, u.pn); u.kind = 0; u.A = WINT + (size_t)u.pm * 256 * D * 2; u.B = HX + (size_t)u.pn * 256 * D * 2; return true; }
        if (Lid < 384 + 192) { tile_of((int)Lid - 384, 64, 3, u.pm, u.pn); u.kind = u.pn < 2 ? 1 : 2; u.A = HX + (size_t)u.pm * 256 * D * 2; u.B = WINT + (size_t)(OFF_Q + u.pn * 256) * D * 2; return true; }
        if (Lid < 384 + 192 + 8) { u.pm = 64 + (int)(Lid - 576); u.pn = 2; u.kind = 3; u.A = HX + (size_t)u.pm * 256 * D * 2; u.B = WINT + (size_t)(OFF_Q + 512) * D * 2; return true; }
        return false;
    }
};
struct SchedGate {
    const char* HX8; const char* WG8; int G, c;
    __device__ __forceinline__ bool next(int i, Unit& u) const {
        long Lid;
        if (G == 256) { if (i == 0) Lid = c; else if (i == 1 && c >= 72) Lid = 256 + (c - 72); else if (i == 2 && c >= 72 && c < 144) Lid = 440 + (c - 72); else return false; }
        else { Lid = (long)i * G + c; if (Lid >= 512) return false; }
        tile_of((int)Lid, 64, 8, u.pm, u.pn); u.kind = 1;
        u.A = HX8 + (size_t)u.pm * 256 * D; u.B = WG8 + (size_t)u.pn * 256 * D; u.pn += 3; return true;
    }
};
struct SchedP5a {
    const char* YAT; const char* WAT; int c;
    __device__ __forceinline__ bool next(int i, Unit& u) const { if (i > 0) return false; tile_of(c, 64, 4, u.pm, u.pn); u.kind = 0;
        u.A = YAT + (size_t)u.pm * 256 * 2; u.B = WAT + (size_t)u.pn * 256 * HW * 2; return true; }
};
struct SchedP5b {
    const char* YB; const char* WBT; int c;
    __device__ __forceinline__ bool next(int i, Unit& u) const { if (i > 0) return false; tile_of(c, 64, 4, u.pm, u.pn); u.kind = 1;
        u.A = YB + (size_t)u.pm * 256 * HW * 2; u.B = WBT + (size_t)u.pn * 256 * HW * 2; return true; }
};
struct SchedP5 {
    const char* YA; const char* WAT; const char* YB; const char* WBT; int G, c;
    __device__ __forceinline__ bool next(int i, Unit& u) const {
        const long tile = (long)(i >> 1) * G + c; if (tile >= 256) return false;
        tile_of((int)tile, 64, 4, u.pm, u.pn); u.kind = i & 1;
        u.A = ((i & 1) ? YB : YA) + (size_t)u.pm * 256 * HW * 2; u.B = ((i & 1) ? WBT : WAT) + (size_t)u.pn * 256 * HW * 2; return true;
    }
};
}

struct UnitsStd {
    const bf16* A; const bf16* Bt; int lda, ldb, nM, nN; size_t bgroup;
    __device__ __forceinline__ bool get(int idx, int& pm, int& pn, const bf16*& Ab, const bf16*& Bb) const {
        if (idx >= nM * nN) return false;
        pm = idx / nN; pn = idx % nN;
        Ab = A + (size_t)pm * 256 * lda; Bb = Bt + (size_t)(pm >> 3) * bgroup + (size_t)pn * 256 * ldb; return true;
    }
};
struct UnitsIn {
    const bf16* A; const bf16* Bt;
    __device__ __forceinline__ bool get(int idx, int& pm, int& pn, const bf16*& Ab, const bf16*& Bb) const {
        if (idx < 64 * 11) { pm = idx / 11; pn = idx % 11; }
        else if (idx < 64 * 11 + 8) { pm = 64 + (idx - 64 * 11); pn = 2; }
        else return false;
        Ab = A + (size_t)pm * 256 * D; Bb = Bt + (size_t)pn * 256 * D; return true;
    }
};

struct EpiInB {
    bf16 *ZT, *Q, *Kr, *V, *KC, *VC;
    __device__ __forceinline__ bool carry(const pg8::Unit&) const { return false; }
    __device__ __forceinline__ void operator()(const f32x4 (&acc)[2][2][4][2], const pg8::Unit& u, int wr, int wc, int fr, int fq) const {
        bf16 *d0, *d1; size_t ld;
        if (u.kind == 0) { d0 = ZT + ((size_t)((u.pn >> 3) * 1536 + u.pm * 256)) * 2048 + (u.pn & 7) * 256; d1 = d0 + 128; ld = 2048; }
        else if (u.kind == 1) { d0 = Q + (size_t)u.pm * 256 * QW + u.pn * 256; d1 = d0 + 128; ld = QW; }
        else if (u.kind == 2) { d0 = Kr + (size_t)u.pm * 256 * KVW; d1 = V + (size_t)u.pm * 256 * KVW; ld = KVW; }
        else { d0 = KC + (size_t)(u.pm - 64) * 256 * KVW; d1 = VC + (size_t)(u.pm - 64) * 256 * KVW; ld = KVW; }
        const size_t o = (size_t)(wr * 64 + fr) * ld + wc * 32 + 8 * fq;
#pragma unroll
        for (int ai = 0; ai < 2; ++ai)
#pragma unroll
            for (int m = 0; m < 4; ++m) {
                const float v0[8] = {acc[ai][0][m][0][0], acc[ai][0][m][0][1], acc[ai][0][m][0][2], acc[ai][0][m][0][3], acc[ai][0][m][1][0], acc[ai][0][m][1][1], acc[ai][0][m][1][2], acc[ai][0][m][1][3]};
                const float v1[8] = {acc[ai][1][m][0][0], acc[ai][1][m][0][1], acc[ai][1][m][0][2], acc[ai][1][m][0][3], acc[ai][1][m][1][0], acc[ai][1][m][1][1], acc[ai][1][m][1][2], acc[ai][1][m][1][3]};
                const size_t oo = o + (size_t)(ai * 128 + m * 16) * ld;
                *(v4u*)(d0 + oo) = pack8(v0); *(v4u*)(d1 + oo) = pack8(v1);
            }
    }
};
struct EpiGate {
    unsigned char *GA, *GB;
    __device__ __forceinline__ bool carry(const pg8::Unit&) const { return false; }
    __device__ __forceinline__ void operator()(const f32x4 (&acc)[2][2][4][2], const pg8::Unit& u, int wr, int wc, int fr, int fq) const {
        unsigned char* d = (u.pn < 7 ? GA + (u.pn - 3) * 256 : GB + (u.pn - 7) * 256) + (size_t)(u.pm * 256 + wr * 64 + fr) * D + wc * 32 + 8 * fq;
#pragma unroll
        for (int ai = 0; ai < 2; ++ai)
#pragma unroll
            for (int m = 0; m < 4; ++m)
#pragma unroll
                for (int bj = 0; bj < 2; ++bj) {
                    unsigned q[8];
#pragma unroll
                    for (int j = 0; j < 8; ++j) q[j] = (unsigned)(sigmf(acc[ai][bj][m][j >> 2][j & 3]) * 255.f + 0.5f);
                    v2u w; w.x = q[0] | (q[1] << 8) | (q[2] << 16) | (q[3] << 24); w.y = q[4] | (q[5] << 8) | (q[6] << 16) | (q[7] << 24);
                    *(v2u*)(d + (size_t)(ai * 128 + m * 16) * D + bj * 128) = w;
                }
    }
};
struct EpiOutFused {
    const float* x; const float* mod; bf16* xnew; const float* GRT; float* UPART; float* SSQP;
    __device__ __forceinline__ void fused(const f32x4 (&acc)[2][2][4][2], const pg8::Unit& u, int wr, int wc, int fr, int fq, LAS unsigned char* lds) const {
        const int tid = threadIdx.x, b = (u.pm * 256) >> 11;
        LAS float* UPL = (LAS float*)lds;
        LAS float* SSL = (LAS float*)(lds + 65536);
        bf16x8 Bh[2], Bl[2];
#pragma unroll
        for (int bj = 0; bj < 2; ++bj) {
            const float* gp = GRT + ((size_t)(b * 16 + fr)) * D + u.pn * 256 + bj * 128 + wc * 32 + 8 * fq;
            const f32x4 g0 = *(const f32x4*)gp, g1v = *(const f32x4*)(gp + 4);
            const float g[8] = {g0[0], g0[1], g0[2], g0[3], g1v[0], g1v[1], g1v[2], g1v[3]};
            unsigned h[4], l[4];
#pragma unroll
            for (int j = 0; j < 4; ++j) { h[j] = cvtpk(g[2 * j], g[2 * j + 1]); l[j] = cvtpk(g[2 * j] - bflo(h[j]), g[2 * j + 1] - bfhi(h[j])); }
            v4u ph; ph.x = h[0]; ph.y = h[1]; ph.z = h[2]; ph.w = h[3]; v4u pl; pl.x = l[0]; pl.y = l[1]; pl.z = l[2]; pl.w = l[3];
            Bh[bj] = __builtin_bit_cast(bf16x8, ph); Bl[bj] = __builtin_bit_cast(bf16x8, pl);
        }
        f32x4 g1q[2][2];
#pragma unroll
        for (int bj = 0; bj < 2; ++bj) { const float* g1 = mod + (size_t)b * MODW + 2 * D + u.pn * 256 + bj * 128 + wc * 32 + 8 * fq; g1q[bj][0] = *(const f32x4*)g1; g1q[bj][1] = *(const f32x4*)(g1 + 4); }
#pragma unroll
        for (int ai = 0; ai < 2; ++ai)
#pragma unroll
          for (int mp = 0; mp < 2; ++mp) {
            f32x4 xq[2][2][2];
#pragma unroll
            for (int mm = 0; mm < 2; ++mm)
#pragma unroll
                for (int bj = 0; bj < 2; ++bj) { const float* xr = x + (size_t)(u.pm * 256 + ai * 128 + wr * 64 + (2 * mp + mm) * 16 + fr) * D + u.pn * 256 + bj * 128 + wc * 32 + 8 * fq;
                    xq[mm][bj][0] = *(const f32x4*)xr; xq[mm][bj][1] = *(const f32x4*)(xr + 4); }
            __builtin_amdgcn_sched_barrier(0);
#pragma unroll
            for (int mm = 0; mm < 2; ++mm) {
                const int m = 2 * mp + mm;
                const int rl = ai * 128 + wr * 64 + m * 16, row = u.pm * 256 + rl + fr;
                f32x4 d = {0.f, 0.f, 0.f, 0.f}; float ssq = 0.f;
#pragma unroll
                for (int bj = 0; bj < 2; ++bj) {
                    const int col = u.pn * 256 + bj * 128 + wc * 32 + 8 * fq;
                    const f32x4 x0 = xq[mm][bj][0], x1 = xq[mm][bj][1], ga = g1q[bj][0], gb = g1q[bj][1];
                    f32x4 o0, o1;
#pragma unroll
                    for (int j = 0; j < 4; ++j) { o0[j] = x0[j] + ga[j] * acc[ai][bj][m][0][j]; o1[j] = x1[j] + gb[j] * acc[ai][bj][m][1][j]; }
                    ssq += ((o0[0] * o0[0] + o0[1] * o0[1]) + (o0[2] * o0[2] + o0[3] * o0[3])) + ((o1[0] * o1[0] + o1[1] * o1[1]) + (o1[2] * o1[2] + o1[3] * o1[3]));
                    const float ov[8] = {o0[0], o0[1], o0[2], o0[3], o1[0], o1[1], o1[2], o1[3]};
                    unsigned h[4], l[4];
#pragma unroll
                    for (int j = 0; j < 4; ++j) { h[j] = cvtpk(ov[2 * j], ov[2 * j + 1]); l[j] = cvtpk(ov[2 * j] - bflo(h[j]), ov[2 * j + 1] - bfhi(h[j])); }
                    v4u ph; ph.x = h[0]; ph.y = h[1]; ph.z = h[2]; ph.w = h[3]; v4u pl; pl.x = l[0]; pl.y = l[1]; pl.z = l[2]; pl.w = l[3];
                    *(v4u*)(xnew + (size_t)row * D + col) = ph;
                    const bf16x8 Ah = __builtin_bit_cast(bf16x8, ph), Al = __builtin_bit_cast(bf16x8, pl);
                    d = __builtin_amdgcn_mfma_f32_16x16x32_bf16(Ah, Bh[bj], d, 0, 0, 0);
                    d = __builtin_amdgcn_mfma_f32_16x16x32_bf16(Ah, Bl[bj], d, 0, 0, 0);
                    d = __builtin_amdgcn_mfma_f32_16x16x32_bf16(Al, Bh[bj], d, 0, 0, 0);
                }
                ssq += __shfl_xor(ssq, 16); ssq += __shfl_xor(ssq, 32);
                if (fq == 0) SSL[wc * 256 + rl + fr] = ssq;
#pragma unroll
                for (int i = 0; i < 4; ++i) UPL[(wc * 256 + rl + 4 * fq + i) * 16 + fr] = d[i];
            }
            __builtin_amdgcn_sched_barrier(0);
          }
        LDS_BARRIER();
#pragma unroll
        for (int k = 0; k < 8; ++k) { const int idx = tid + 512 * k, r = idx >> 4, e = idx & 15;
            const float sum = (UPL[(0 * 256 + r) * 16 + e] + UPL[(1 * 256 + r) * 16 + e]) + (UPL[(2 * 256 + r) * 16 + e] + UPL[(3 * 256 + r) * 16 + e]);
            UPART[((size_t)u.pn * M + u.pm * 256 + r) * 16 + e] = sum; }
        if (tid < 256) SSQP[(size_t)u.pn * M + u.pm * 256 + tid] = (SSL[tid] + SSL[256 + tid]) + (SSL[512 + tid] + SSL[768 + tid]);
    }
    __device__ __forceinline__ void operator()(const f32x4 (&)[2][2][4][2], const pg8::Unit&, int, int, int, int) const {}
    __device__ __forceinline__ bool carry(const pg8::Unit&) const { return false; }
};
struct EpiH {
    unsigned char* HB;
    __device__ __forceinline__ void operator()(int row, int pn, int c8, const float* v0, const float* v1) const {
        float o[8];
#pragma unroll
        for (int j = 0; j < 8; ++j) o[j] = siluf(v0[j]) * v1[j];
        v2u w; w.x = pk4_fp8(o[0], o[1], o[2], o[3]); w.y = pk4_fp8(o[4], o[5], o[6], o[7]);
        *(v2u*)(HB + (size_t)row * DFF + pn * 128 + c8) = w;
    }
};
struct EpiY {
    const float* selg; const float* mod; unsigned char* Y;
    __device__ __forceinline__ void one(int row, int n, const float* v) const {
        const float g = selg[row] * 32.f; const float* g2 = mod + (size_t)((row >> 8) & 7) * MODW + 5 * D + n; float o[8];
#pragma unroll
        for (int j = 0; j < 8; ++j) o[j] = v[j] * g * g2[j];
        v2u w; w.x = pk4_fp8(o[0], o[1], o[2], o[3]); w.y = pk4_fp8(o[4], o[5], o[6], o[7]);
        *(v2u*)(Y + (size_t)row * D + n) = w;
    }
    __device__ __forceinline__ void operator()(int row, int pn, int c8, const float* v0, const float* v1) const { one(row, pn * 256 + c8, v0); one(row, pn * 256 + 128 + c8, v1); }
};
struct EpiY2 {
    const float* selg; const float* mod; unsigned char* Y;
    __device__ __forceinline__ bool carry(const pg8::Unit&) const { return false; }
    __device__ __forceinline__ void operator()(const f32x4 (&acc)[2][2][4][2], const pg8::Unit& u, int wr, int wc, int fr, int fq) const {
        const int row0 = u.pm * 256 + wr * 64 + fr, col0 = u.pn * 256 + wc * 32 + 8 * fq;
        const float* g2p = mod + (size_t)(u.pm & 7) * MODW + 5 * D + col0;
        f32x4 g2q[2][2]; float sg[2][4];
#pragma unroll
        for (int bj = 0; bj < 2; ++bj) { g2q[bj][0] = *(const f32x4*)(g2p + bj * 128); g2q[bj][1] = *(const f32x4*)(g2p + bj * 128 + 4); }
#pragma unroll
        for (int ai = 0; ai < 2; ++ai)
#pragma unroll
            for (int m = 0; m < 4; ++m) sg[ai][m] = selg[row0 + ai * 128 + m * 16] * 32.f;
        __builtin_amdgcn_sched_barrier(0);
#pragma unroll
        for (int ai = 0; ai < 2; ++ai)
#pragma unroll
            for (int m = 0; m < 4; ++m)
#pragma unroll
                for (int bj = 0; bj < 2; ++bj) {
                    float o[8];
#pragma unroll
                    for (int j = 0; j < 8; ++j) o[j] = acc[ai][bj][m][j >> 2][j & 3] * sg[ai][m] * g2q[bj][j >> 2][j & 3];
                    v2u w; w.x = pk4_fp8(o[0], o[1], o[2], o[3]); w.y = pk4_fp8(o[4], o[5], o[6], o[7]);
                    *(v2u*)(Y + (size_t)(row0 + ai * 128 + m * 16) * D + col0 + bj * 128) = w;
                }
    }
};
template <class F> struct K0 { F f; __device__ __forceinline__ void operator()(int kind, int row, int pn, int c8, const float* v0, const float* v1) const { f(row, pn, c8, v0, v1); } };
struct EpiP5C {
    const unsigned char* GA; const unsigned char* GB; bf16* MMo;
    __device__ __forceinline__ bool carry(const pg8::Unit& u) const { return u.kind == 0; }
    __device__ __forceinline__ void operator()(f32x4 (&acc)[2][2][4][2], const pg8::Unit& u, int wr, int wc, int fr, int fq) const {
        const size_t base = (size_t)(u.pm * 256 + wr * 64 + fr) * D + u.pn * 256 + wc * 32 + 8 * fq;
        if (u.kind == 0) {
#pragma unroll
            for (int ai = 0; ai < 2; ++ai) {
                v2u ga[8], gb[8];
#pragma unroll
                for (int m = 0; m < 4; ++m)
#pragma unroll
                    for (int bj = 0; bj < 2; ++bj) { const size_t o = base + (size_t)(ai * 128 + m * 16) * D + bj * 128; ga[m * 2 + bj] = *(const v2u*)(GA + o); gb[m * 2 + bj] = *(const v2u*)(GB + o); }
                __builtin_amdgcn_sched_barrier(0);
#pragma unroll
                for (int m = 0; m < 4; ++m)
#pragma unroll
                    for (int bj = 0; bj < 2; ++bj) {
                        float a[8], b[8]; unpack8_u8(ga[m * 2 + bj], a); unpack8_u8(gb[m * 2 + bj], b);
#pragma unroll
                        for (int j = 0; j < 4; ++j) { acc[ai][bj][m][0][j] *= a[j] * __builtin_amdgcn_rcpf(fmaxf(b[j], 0.5f / 255.f)); acc[ai][bj][m][1][j] *= a[4 + j] * __builtin_amdgcn_rcpf(fmaxf(b[4 + j], 0.5f / 255.f)); }
                    }
                __builtin_amdgcn_sched_barrier(0);
            }
        } else {
#pragma unroll
            for (int ai = 0; ai < 2; ++ai) {
                v2u gb[8];
#pragma unroll
                for (int m = 0; m < 4; ++m)
#pragma unroll
                    for (int bj = 0; bj < 2; ++bj) gb[m * 2 + bj] = *(const v2u*)(GB + base + (size_t)(ai * 128 + m * 16) * D + bj * 128);
                __builtin_amdgcn_sched_barrier(0);
#pragma unroll
                for (int m = 0; m < 4; ++m)
#pragma unroll
                    for (int bj = 0; bj < 2; ++bj) {
                        const size_t o = base + (size_t)(ai * 128 + m * 16) * D + bj * 128;
                        float b[8], r[8]; unpack8_u8(gb[m * 2 + bj], b);
#pragma unroll
                        for (int j = 0; j < 4; ++j) { r[j] = fmaxf(b[j], 0.5f / 255.f) * acc[ai][bj][m][0][j]; r[4 + j] = fmaxf(b[4 + j], 0.5f / 255.f) * acc[ai][bj][m][1][j]; }
                        *(v4u*)(MMo + o) = pack8(r);
                    }
                __builtin_amdgcn_sched_barrier(0);
            }
        }
    }
};

struct TrItem { const float* W; bf16* WT; int N, ldt, k0, n0, drow0, fp8; };
__device__ __forceinline__ void tr_load(const TrItem& T, int lane, f32x4 (&v)[8]) {
    const float* p = T.W + (size_t)(T.k0 + 8 * (lane & 7)) * T.N + T.n0 + 4 * (lane >> 3);
#pragma unroll
    for (int j = 0; j < 8; ++j) v[j] = __builtin_nontemporal_load((const f32x4*)(p + (size_t)j * T.N));
}
__device__ __forceinline__ void tr_store(const TrItem& T, int lane, const f32x4 (&v)[8]) {
    if (T.fp8) {
        unsigned char* q = (unsigned char*)T.WT + (size_t)(T.drow0 + 4 * (lane >> 3)) * T.ldt + T.k0 + 8 * (lane & 7);
#pragma unroll
        for (int i = 0; i < 4; ++i) { v2u o; o.x = pk4_fp8(32.f * v[0][i], 32.f * v[1][i], 32.f * v[2][i], 32.f * v[3][i]); o.y = pk4_fp8(32.f * v[4][i], 32.f * v[5][i], 32.f * v[6][i], 32.f * v[7][i]);
            *(v2u*)(q + (size_t)i * T.ldt) = o; }
    } else {
        bf16* q = T.WT + (size_t)(T.drow0 + 4 * (lane >> 3)) * T.ldt + T.k0 + 8 * (lane & 7);
#pragma unroll
        for (int i = 0; i < 4; ++i) { v4u o; o.x = pk2(v[0][i], v[1][i]); o.y = pk2(v[2][i], v[3][i]); o.z = pk2(v[4][i], v[5][i]); o.w = pk2(v[6][i], v[7][i]);
            *(v4u*)(q + (size_t)i * T.ldt) = o; }
    }
}
constexpr int TR_NITEMS = (D / 64) * (INW / 32) + 2 * (HW / 64) * (D / 32) + (D / 64) * (D / 32) + NE * (2 * (D / 64) * (DFF / 32) + (DFF / 64) * (D / 32));
constexpr int TR_TAIL = 112 * NWAVES * 4;
constexpr int TR_SL_HY = 256 * NWAVES * 16;
constexpr int TR_SL_AT = 128 * NWAVES * 4;
constexpr int TR_SL_RP = 0;
constexpr int TR_SL_TT = 0;
constexpr int TR_SL_TK = 256 * NWAVES * 2;
constexpr int TR_P0 = TR_NITEMS - TR_TAIL - TR_SL_HY - TR_SL_AT - TR_SL_RP - TR_SL_TT - TR_SL_TK, TR_HY0 = TR_P0, TR_AT0 = TR_HY0 + TR_SL_HY, TR_RP0 = TR_AT0 + TR_SL_AT, TR_TT0 = TR_RP0 + TR_SL_RP, TR_TK0 = TR_TT0 + TR_SL_TT;
static_assert(TR_P0 >= (D / 64) * (INW / 32) + 2 * (HW / 64) * (D / 32) + (D / 64) * (D / 32), "prologue slice covers the non-expert weights");
__device__ __forceinline__ bool tr_item(const Ctx& C, int it, TrItem& T) {
    constexpr int I_IN = (D / 64) * (INW / 32), I_A = (HW / 64) * (D / 32), I_O = (D / 64) * (D / 32), I_G = (D / 64) * (DFF / 32), I_D = (DFF / 64) * (D / 32);
    constexpr int NITEMS = I_IN + 2 * I_A + I_O + NE * (2 * I_G + I_D);
    if (it >= NITEMS || it < 0) return false;
    int r = it;
    if (r < I_IN) { const int nblk = INW / 32, kb = r / nblk, nbk = r % nblk;
        if (nbk * 32 < OFF_G) T = TrItem{C.in[IN_WIN], (bf16*)(C.ws + WS_WINT), INW, D, kb * 64, nbk * 32, nbk * 32, 0};
        else T = TrItem{C.in[IN_WIN], (bf16*)(C.ws + WS_WG8), INW, D, kb * 64, nbk * 32, nbk * 32 - OFF_G, 1};
        return true; } r -= I_IN;
    if (r < I_A) { const int nblk = D / 32, kb = r / nblk, nbk = r % nblk; T = TrItem{C.in[IN_WA], (bf16*)(C.ws + WS_WAT), D, HW, kb * 64, nbk * 32, nbk * 32, 0}; return true; } r -= I_A;
    if (r < I_A) { const int nblk = D / 32, kb = r / nblk, nbk = r % nblk; T = TrItem{C.in[IN_WB], (bf16*)(C.ws + WS_WBT), D, HW, kb * 64, nbk * 32, nbk * 32, 0}; return true; } r -= I_A;
    if (r < I_O) { const int nblk = D / 32, kb = r / nblk, nbk = r % nblk; T = TrItem{C.in[IN_WOUT], (bf16*)(C.ws + WS_WOUTT), D, D, kb * 64, nbk * 32, nbk * 32, 0}; return true; } r -= I_O;
    const int e = r / (2 * I_G + I_D); r -= e * (2 * I_G + I_D);
    if (r < 2 * I_G) { const int which = r / I_G; r -= which * I_G; const int nblk = DFF / 32, kb = r / nblk, nbk = r % nblk, f0 = nbk * 32;
        T = TrItem{(which ? C.in[IN_WUP] : C.in[IN_WGATE]) + (size_t)e * D * DFF, (bf16*)(C.ws + WS_W1T), DFF, D, kb * 64, f0, e * 4096 + 256 * (f0 >> 7) + 128 * which + (f0 & 127), 1}; return true; }
    r -= 2 * I_G;
    { const int nblk = D / 32, kb = r / nblk, nbk = r % nblk; T = TrItem{C.in[IN_WDOWN] + (size_t)e * DFF * D, (bf16*)(C.ws + WS_W2T), D, DFF, kb * 64, nbk * 32, e * 1024 + nbk * 32, 1}; return true; }
}
struct ConvSlice { int it, left; };
__device__ __forceinline__ ConvSlice conv_slice(const Ctx& C, int base, int per_wave) { ConvSlice q; q.it = base + (C.bid * NWAVES + C.wave) * per_wave; q.left = (C.nb == 256) ? per_wave : 0; return q; }
__device__ __forceinline__ ConvSlice conv_slice_hy(const Ctx& C) {
    ConvSlice q; q.it = TR_HY0 + (C.bid * 4 + (C.wave & 3)) * 32; q.left = (C.nb == 256 && C.wave >= 4 && !(C.sub & 128)) ? 32 : 0; return q; }
__device__ __forceinline__ void conv_flush(const Ctx& C, ConvSlice& q) {
    while (q.left > 0) { TrItem T; f32x4 v[8]; tr_item(C, q.it, T); tr_load(T, C.lane, v); tr_store(T, C.lane, v); q.it += 1; q.left -= 1; }
}

__device__ __forceinline__ void hx_rows(const Ctx& C);
__device__ __forceinline__ void p0_phase(const Ctx& C) {
    const int gw = C.bid * NWAVES + C.wave, NGW = C.nb * NWAVES, lane = C.lane;
    float* mod = (float*)(C.ws + WS_MOD);
    {
        LAS float* sc = (LAS float*)C.lds;
        LAS float* red = sc + 9 * 1024;
        bool have_sc = false;
        for (int cb = C.bid; cb < MODW / 32; cb += C.nb) {
            const int cl = C.tid & 31, kg = C.tid >> 5, n = cb * 32 + cl;
            float w[64];
            const unsigned toff = (unsigned)(kg * MODW + n);
#pragma unroll
            for (int u = 0; u < 64; ++u) { const float* rowbase = C.in[IN_ADAW] + (size_t)16 * u * MODW; w[u] = __builtin_nontemporal_load(rowbase + toff); }
            if (!have_sc) {
                float cv[18];
#pragma unroll
                for (int j = 0; j < 18; ++j) cv[j] = (j < 16) ? C.in[IN_C][C.tid + NT * j] : C.in[IN_CCTX][C.tid + NT * (j - 16)];
#pragma unroll
                for (int j = 0; j < 18; ++j) sc[C.tid + NT * j] = siluf(cv[j]);
                __syncthreads(); have_sc = true;
            }
            float a[9];
#pragma unroll
            for (int r = 0; r < 9; ++r) a[r] = 0.f;
#pragma unroll
            for (int u = 0; u < 64; ++u)
#pragma unroll
                for (int r = 0; r < 9; ++r) a[r] += sc[r * 1024 + kg + 16 * u] * w[u];
#pragma unroll
            for (int r = 0; r < 9; ++r) red[(kg * 9 + r) * 32 + cl] = a[r];
            __syncthreads();
            if (C.tid < 9 * 32) { const int r = C.tid >> 5, c2 = C.tid & 31; float s = 0.f;
                for (int g = 0; g < 16; ++g) s += red[(g * 9 + r) * 32 + c2];
                mod[(size_t)r * MODW + cb * 32 + c2] = s + C.in[IN_ADAB][cb * 32 + c2]; }
            __syncthreads();
        }
    }
    sb_arrive((unsigned*)(C.ws + WS_CTL) + CW_SB0);
    {
        float* H3 = (float*)(C.ws + WS_H3);
        const double PI2 = 6.283185307179586476925286766559;
        for (int pos = gw; pos < L; pos += NGW) {
            double feat = 0.0;
            {
                const double t = (double)pos / (double)(L - 1), w = PI2 * (double)pos / (double)L;
                if (lane == 0) feat = t;
                else if (lane <= 32) { const int b = (lane - 1) & 15; const double fr = 1e-4 + (15.0 - 1e-4) * (double)b / 15.0; feat = (lane <= 16) ? cos(fr * w) : -sin(fr * w); }
            }
            const double fq = (double)C.in[IN_FFREQ][lane];
            double acc = (double)C.in[IN_FB1][lane];
            for (int k = 0; k < 33; ++k) acc += __shfl(feat, k) * (double)C.in[IN_FW1][k * 64 + lane];
            double h = sin(fq * acc);
            acc = (double)C.in[IN_FB2][lane];
            for (int k = 0; k < 64; ++k) acc += __shfl(h, k) * (double)C.in[IN_FW2][k * 64 + lane];
            h = sin(fq * acc);
            acc = (double)C.in[IN_FB3][lane];
            for (int k = 0; k < 64; ++k) acc += __shfl(h, k) * (double)C.in[IN_FW3][k * 64 + lane];
            h = sin(fq * acc);
            H3[(size_t)lane * L + pos] = (float)h;
        }
    }
    {
        float* R = (float*)(C.ws + WS_ROPE);
        for (int i = C.bid * NT + C.tid; i < L * 32; i += C.nb * NT) {
            const int pos = i >> 5, a = i & 31; const int m = a & 15;
            const double inv = pow(10000.0, -(double)m / 16.0);
            const double p = (a < 16) ? (double)(pos >> 6) : (double)(pos & 63);
            const double ang = p * inv;
            R[2 * i] = (float)cos(ang); R[2 * i + 1] = (float)sin(ang);
        }
    }
    {
        TrItem Ta, Tb; f32x4 va[8], vb[8];
        for (int it = gw; ; it += 2 * NGW) {
            const int lim = (C.nb == 256) ? TR_P0 : TR_NITEMS;
            const bool ha = (it < lim) && tr_item(C, it, Ta), hb = (it + NGW < lim) && tr_item(C, it + NGW, Tb);
            if (!ha) break;
            tr_load(Ta, lane, va); if (hb) tr_load(Tb, lane, vb);
            tr_store(Ta, lane, va); if (hb) tr_store(Tb, lane, vb);
        }
    }
    sb_wait((unsigned*)(C.ws + WS_CTL) + CW_SB0, (unsigned)C.nb, (unsigned*)(C.ws + WS_CTL) + CW_BAR + XB_TMO);
    {
        float* GRT = (float*)(C.ws + WS_GRT); float* CB = (float*)(C.ws + WS_CB);
        for (int i = C.bid * NT + C.tid; i < NB * NE * D; i += C.nb * NT) { const int c = i & (D - 1), e = (i >> 10) & 15, b = i >> 14;
            GRT[i] = C.in[IN_NORM2][c] * (1.f + mod[(size_t)b * MODW + 4 * D + c]) * C.in[IN_ROUTER][c * 16 + e]; }
    }
    hx_rows(C);
    if (C.wave == 7) {
        float* CB = (float*)(C.ws + WS_CB);
        for (int item = C.bid; item < NB * NE; item += C.nb) { const int b = item >> 4, e = item & 15;
            float mv[16], rv[16];
#pragma unroll
            for (int k = 0; k < 16; ++k) { mv[k] = mod[(size_t)b * MODW + 3 * D + lane + 64 * k]; rv[k] = C.in[IN_ROUTER][(lane + 64 * k) * 16 + e]; }
            __builtin_amdgcn_sched_barrier(0);
            float a = 0.f;
#pragma unroll
            for (int k = 0; k < 16; ++k) a += mv[k] * rv[k];
            a = wave_sum(a); if (lane == 0) CB[item] = a; }
    }
}

__device__ __forceinline__ void tap_table(const Ctx& C) {
    {
        const float* H3T = (const float*)(C.ws + WS_H3); bf16* GT = (bf16*)(C.ws + WS_GTAB);
        const float min_decay = -3.0701134573253946f, max_decay = -15.350567286626973f;
        ConvSlice tq = conv_slice(C, TR_TT0, 0);
        for (int c0 = C.bid; c0 < HW / 2; c0 += C.nb) {
            float a[2][4][4];
#pragma unroll
            for (int cc = 0; cc < 2; ++cc)
#pragma unroll
                for (int kk = 0; kk < 4; ++kk)
#pragma unroll
                    for (int q = 0; q < 4; ++q) a[cc][kk][q] = 0.f;
            const float* fo = C.in[IN_FOUT] + c0;
#pragma unroll 1
            for (int kq = 0; kq < 4; ++kq) {
            TrItem Ta; f32x4 cva[8]; const bool cv = tq.left > 0;
            if (cv) { tr_item(C, tq.it, Ta); tr_load(Ta, C.lane, cva); }
#pragma unroll 16
            for (int k = kq * 16; k < kq * 16 + 16; ++k) {
                float hv[4];
#pragma unroll
                for (int kk = 0; kk < 4; ++kk) hv[kk] = H3T[(size_t)k * L + C.tid + 512 * kk];
#pragma unroll
                for (int cc = 0; cc < 2; ++cc)
#pragma unroll
                    for (int q = 0; q < 4; ++q) { const float f = fo[(size_t)k * 2048 + q * 512 + cc * 256];
#pragma unroll
                        for (int kk = 0; kk < 4; ++kk) a[cc][kk][q] += hv[kk] * f; }
            }
            if (cv) { tr_store(Ta, C.lane, cva); tq.it += 1; tq.left -= 1; }
            }
#pragma unroll
            for (int cc = 0; cc < 2; ++cc) {
                const int c = c0 + cc * 256;
                const float delta = fabsf(min_decay + (max_decay - min_decay) * (float)c / 511.f);
#pragma unroll
                for (int kk = 0; kk < 4; ++kk) {
                    const int t = C.tid + 512 * kk;
                    const float dec = expf(-((float)t / (float)(L - 1)) * delta);
#pragma unroll
                    for (int o = 0; o < 2; ++o) {
                        float f = a[cc][kk][o * 2] * dec, bk = a[cc][kk][o * 2 + 1] * dec;
                        if (t == 0) f += C.in[IN_HBIAS][o * 512 + c];
                        bf16* g = GT + ((size_t)c * 2 + o) * GT_LEN;
                        g[2047 - t] = (bf16)f2bf(f); if (t == 0) g[4095] = (bf16)0; else g[2047 + t] = (bf16)f2bf(bk);
                    }
                }
            }
        }
            conv_flush(C, tq);
    }
}

__device__ __forceinline__ void hx_rows(const Ctx& C) {
    const int gw = C.bid * NWAVES + C.wave, NGW = C.nb * NWAVES, lane = C.lane;
    const float* mod = (const float*)(C.ws + WS_MOD);
    bf16* HX = (bf16*)(C.ws + WS_HX); unsigned char* HX8 = (unsigned char*)(C.ws + WS_HX8);
    const int ngrp = MT / 4, nfull = ngrp / NGW, nrem = ngrp - nfull * NGW;
    for (int itr = 0; itr <= nfull; ++itr) {
        int grp;
        if (itr < nfull) grp = gw + itr * NGW; else { const int jr = C.wave * C.nb + C.bid; if (jr >= nrem) break; grp = nfull * NGW + jr; }
        const int row0 = grp * 4;
        const float* xr = (row0 < M) ? C.in[IN_X] + (size_t)row0 * D : C.in[IN_CTX] + (size_t)(row0 - M) * D;
        const int mb = (row0 < M) ? (row0 >> 11) : 8;
        const float* sh = mod + (size_t)mb * MODW; const float* sc = sh + D;
        f32x4 v[4][4]; float ss[4];
#pragma unroll
        for (int r = 0; r < 4; ++r)
#pragma unroll
            for (int j = 0; j < 4; ++j) v[r][j] = __builtin_nontemporal_load((const f32x4*)(xr + (size_t)r * D + 4 * lane + 256 * j));
        __builtin_amdgcn_sched_barrier(0);
#pragma unroll
        for (int r = 0; r < 4; ++r) { float s2 = 0.f;
#pragma unroll
            for (int j = 0; j < 4; ++j) s2 += (v[r][j][0] * v[r][j][0] + v[r][j][1] * v[r][j][1]) + (v[r][j][2] * v[r][j][2] + v[r][j][3] * v[r][j][3]);
            ss[r] = 1.f / sqrtf(wave_sum(s2) * (1.f / D) + EPS); }
#pragma unroll
        for (int j = 0; j < 4; ++j) {
            const int c0 = 4 * lane + 256 * j; const f32x4 g = *(const f32x4*)(C.in[IN_NORM1] + c0), a = *(const f32x4*)(sc + c0), b = *(const f32x4*)(sh + c0);
            float gm[4];
#pragma unroll
            for (int i = 0; i < 4; ++i) gm[i] = g[i] * (1.f + a[i]);
#pragma unroll
            for (int r = 0; r < 4; ++r) {
                float o[4];
#pragma unroll
                for (int i = 0; i < 4; ++i) o[i] = v[r][j][i] * ss[r] * gm[i] + b[i];
                v2u w; w.x = pk2(o[0], o[1]); w.y = pk2(o[2], o[3]);
                *(v2u*)(HX + (size_t)(row0 + r) * D + c0) = w;
                if (row0 < M) *(unsigned*)(HX8 + (size_t)(row0 + r) * D + c0) = pk4_fp8(o[0], o[1], o[2], o[3]);
            }
        }
    }
}
__device__ __forceinline__ void p1_phase(const Ctx& C) { if (C.nb != 256) tap_table(C); }

__device__ __forceinline__ float conv3(const bf16* u, int t, float w0, float w1, float w2, float cb) {
    const float a = (t > 0) ? bf2f(u[t - 1]) : 0.f, b = bf2f(u[t]), c = (t < L - 1) ? bf2f(u[t + 1]) : 0.f;
    return a * w0 + b * w1 + c * w2 + cb;
}
__device__ __forceinline__ void hyena_naive(const Ctx& C, int c) {
    const bf16* ZT = (const bf16*)(C.ws + WS_ZT); const bf16* GT = (const bf16*)(C.ws + WS_GTAB); bf16* YA = (bf16*)(C.ws + WS_YA);
    LAS float* G = (LAS float*)C.lds;
    LAS bf16* y0 = (LAS bf16*)(G + 4096);
    LAS bf16* y1 = y0 + 8 * 2048;
    const float* cw = C.in[IN_CONVW]; const float* cb = C.in[IN_CONVB];
    __syncthreads();
    for (int i = C.tid; i < 8 * 2048; i += NT) { const int b = i >> 11, t = i & 2047;
        y0[i] = (bf16)f2bf(conv3(ZT + ((size_t)b * 1536 + c) * 2048, t, cw[c], cw[1536 + c], cw[3072 + c], cb[c])); }
    for (int o = 0; o < 2; ++o) {
        LAS bf16* yi = o ? y1 : y0;
        for (int i = C.tid; i < 4096; i += NT) G[i] = bf2f(GT[((size_t)c * 2 + o) * GT_LEN + 4095 - i]);
        __syncthreads();
        const int gc = 512 * (o + 1) + c;
        float acc[4][8];
#pragma unroll
        for (int k = 0; k < 4; ++k)
#pragma unroll
            for (int b = 0; b < 8; ++b) acc[k][b] = 0.f;
        for (int s = 0; s < L; ++s) {
            float yv[8];
#pragma unroll
            for (int b = 0; b < 8; ++b) yv[b] = bf2f(yi[b * 2048 + s]);
#pragma unroll
            for (int k = 0; k < 4; ++k) { const float g = G[2048 + C.tid + 512 * k - s];
#pragma unroll
                for (int b = 0; b < 8; ++b) acc[k][b] += g * yv[b]; }
        }
#pragma unroll
        for (int k = 0; k < 4; ++k)
#pragma unroll
            for (int b = 0; b < 8; ++b) { const int t = C.tid + 512 * k;
                const float gate = conv3(ZT + ((size_t)b * 1536 + gc) * 2048, t, cw[gc], cw[1536 + gc], cw[3072 + gc], cb[gc]);
                const float r = gate * acc[k][b];
                if (o == 0) y1[b * 2048 + t] = (bf16)f2bf(r); else YA[((size_t)b * 2048 + t) * HW + c] = (bf16)f2bf(r); }
        __syncthreads();
    }
}


typedef float f32x16 __attribute__((ext_vector_type(16)));
constexpr int HY_YROW = 4496, HY_Y0 = 0, HY_Y1 = 35968, HY_TAP = 71936, HY_CS = 8256, HY_TMP = 137984;
static_assert(HY_TMP + 8192 + 16 <= MISC_OFF, "hyena LDS map");
template <int ORDER>
__device__ __forceinline__ void hyena_conv(const Ctx& C, int c, ConvSlice& cq) {
    const int lane = C.lane;
    if (C.wave >= 4) {
        __builtin_amdgcn_s_setprio(2);
#pragma unroll 1
        for (int r = 0; r < 2; ++r) {
            if (cq.left >= 4) {
                TrItem T0; tr_item(C, cq.it, T0);
                TrItem T1 = T0, T2 = T0, T3 = T0; T1.n0 += 32; T1.drow0 += 32; T2.n0 += 64; T2.drow0 += 64; T3.n0 += 96; T3.drow0 += 96;
                f32x4 v0[8], v1[8], v2[8], v3[8];
                tr_load(T0, lane, v0); tr_load(T1, lane, v1); tr_load(T2, lane, v2); tr_load(T3, lane, v3);
                tr_store(T0, lane, v0); tr_store(T1, lane, v1); tr_store(T2, lane, v2); tr_store(T3, lane, v3);
                cq.it += 4; cq.left -= 4;
            }
        }
        __builtin_amdgcn_s_setprio(0);
        return;
    }
    const bf16* ZT = (const bf16*)(C.ws + WS_ZT); bf16* YAT = (bf16*)(C.ws + WS_YAT);
    const float* cw = C.in[IN_CONVW]; const float* cbp = C.in[IN_CONVB];
    const int w = C.wave, p = lane & 31, h = lane >> 5;
    const int m = 7 - (p & 7), pa = p >> 3, il = p & 3, b = p >> 2;
    const int yin = ORDER ? HY_Y1 : HY_Y0;
    const int I0 = 4 * w, dlo = 4 * I0 - 63;
    const LAS unsigned char* ap = C.lds + HY_TAP + m * HY_CS + 16 * (255 - pa + h) - 64 * dlo;
    const LAS unsigned char* bp = C.lds + yin + b * HY_YROW + 2 * (96 + 32 * (4 * I0 + il) + 8 * h) - 64 * dlo;
    f32x16 acc0, acc1, acc2, acc3;
#pragma unroll
    for (int i = 0; i < 16; ++i) { acc0[i] = 0.f; acc1[i] = 0.f; acc2[i] = 0.f; acc3[i] = 0.f; }
#define HY_LD(p) (*(const LAS bf16x8*)(p))
#define HY_MMA(a, b, c) c = __builtin_amdgcn_mfma_f32_32x32x16_bf16(a, b, c, 0, 0, 0)
    bf16x8 Xa0, Xa1, Xp0, Xp1, Xq0, Xq1, Xr0, Xr1, Xs0, Xs1, Ya0, Ya1, Yp0, Yp1, Yq0, Yq1, Yr0, Yr1, Ys0, Ys1;
#define HY_SB __builtin_amdgcn_sched_barrier(0)
#define HY_PSTEP(Cs, Ns, C0, C1, C2, C3, N0, N1, N2, N3) { \
        Ns##a0 = HY_LD(ap); Ns##a1 = HY_LD(ap + 32); if (C0) HY_MMA(Cs##a0, Cs##p0, acc0); if (C1) HY_MMA(Cs##a0, Cs##q0, acc1); HY_SB; \
        if (N0) { Ns##p0 = HY_LD(bp); Ns##p1 = HY_LD(bp + 32); } if (C2) HY_MMA(Cs##a0, Cs##r0, acc2); HY_SB; if (N1) { Ns##q0 = HY_LD(bp + 256); Ns##q1 = HY_LD(bp + 288); } if (C3) HY_MMA(Cs##a0, Cs##s0, acc3); HY_SB; \
        if (N2) { Ns##r0 = HY_LD(bp + 512); Ns##r1 = HY_LD(bp + 544); } if (C0) HY_MMA(Cs##a1, Cs##p1, acc0); HY_SB; if (N3) { Ns##s0 = HY_LD(bp + 768); Ns##s1 = HY_LD(bp + 800); } if (C1) HY_MMA(Cs##a1, Cs##q1, acc1); HY_SB; \
        if (C2) HY_MMA(Cs##a1, Cs##r1, acc2); if (C3) HY_MMA(Cs##a1, Cs##s1, acc3); HY_SB; ap -= 64; bp -= 64; }
    Xa0 = HY_LD(ap); Xa1 = HY_LD(ap + 32); Xp0 = HY_LD(bp); Xp1 = HY_LD(bp + 32); ap -= 64; bp -= 64;
    HY_PSTEP(X, Y, 1, 0, 0, 0, 1, 0, 0, 0)
    HY_PSTEP(Y, X, 1, 0, 0, 0, 1, 0, 0, 0)
    HY_PSTEP(X, Y, 1, 0, 0, 0, 1, 0, 0, 0)
    HY_PSTEP(Y, X, 1, 0, 0, 0, 1, 1, 0, 0)
    HY_PSTEP(X, Y, 1, 1, 0, 0, 1, 1, 0, 0)
    HY_PSTEP(Y, X, 1, 1, 0, 0, 1, 1, 0, 0)
    HY_PSTEP(X, Y, 1, 1, 0, 0, 1, 1, 0, 0)
    HY_PSTEP(Y, X, 1, 1, 0, 0, 1, 1, 1, 0)
    HY_PSTEP(X, Y, 1, 1, 1, 0, 1, 1, 1, 0)
    HY_PSTEP(Y, X, 1, 1, 1, 0, 1, 1, 1, 0)
    HY_PSTEP(X, Y, 1, 1, 1, 0, 1, 1, 1, 0)
    HY_PSTEP(Y, X, 1, 1, 1, 0, 1, 1, 1, 1)
#pragma unroll 1
    for (int it = 0; it < 27; ++it) { HY_PSTEP(X, Y, 1, 1, 1, 1, 1, 1, 1, 1) HY_PSTEP(Y, X, 1, 1, 1, 1, 1, 1, 1, 1) }
    const int gc = 512 * (ORDER + 1) + c;
    const bf16* ug = ZT + ((size_t)b * 1536 + gc) * 2048;
    v2u gmid[4][4]; unsigned ghalo[4][4];
#pragma unroll
    for (int tile = 0; tile < 4; ++tile)
#pragma unroll
        for (int g = 0; g < 4; ++g) {
            const int t0 = 32 * (4 * (I0 + tile) + il) + 8 * g + 4 * h;
            gmid[tile][g] = *(const v2u*)(ug + t0);
            { const unsigned short x = ug[t0 > 0 ? t0 - 1 : 0], y = ug[t0 + 4 < L ? t0 + 4 : L - 1]; ghalo[tile][g] = ((t0 > 0) ? (unsigned)x : 0u) | (((t0 + 4 < L) ? (unsigned)y : 0u) << 16); }
        }
    HY_PSTEP(X, Y, 1, 1, 1, 1, 0, 1, 1, 1)
    HY_PSTEP(Y, X, 0, 1, 1, 1, 0, 1, 1, 1)
    HY_PSTEP(X, Y, 0, 1, 1, 1, 0, 1, 1, 1)
    HY_PSTEP(Y, X, 0, 1, 1, 1, 0, 1, 1, 1)
    HY_PSTEP(X, Y, 0, 1, 1, 1, 0, 0, 1, 1)
    HY_PSTEP(Y, X, 0, 0, 1, 1, 0, 0, 1, 1)
    HY_PSTEP(X, Y, 0, 0, 1, 1, 0, 0, 1, 1)
    HY_PSTEP(Y, X, 0, 0, 1, 1, 0, 0, 1, 1)
    HY_PSTEP(X, Y, 0, 0, 1, 1, 0, 0, 0, 1)
    HY_PSTEP(Y, X, 0, 0, 0, 1, 0, 0, 0, 1)
    HY_PSTEP(X, Y, 0, 0, 0, 1, 0, 0, 0, 1)
    HY_PSTEP(Y, X, 0, 0, 0, 1, 0, 0, 0, 1)
    HY_MMA(Xa0, Xs0, acc3); HY_MMA(Xa1, Xs1, acc3);
#undef HY_PSTEP
#undef HY_SB
#undef HY_LD
#undef HY_MMA
    if (C.sub & 64) return;
    const float w0 = cw[gc], w1 = cw[1536 + gc], w2 = cw[3072 + gc], cb = cbp[gc];
#pragma unroll
    for (int tile = 0; tile < 4; ++tile) {
#pragma unroll
        for (int g = 0; g < 4; ++g) {
            const int t0 = 32 * (4 * (I0 + tile) + il) + 8 * g + 4 * h;
            const v2u mid = gmid[tile][g];
            const float um1 = bflo(ghalo[tile][g]), up4 = bfhi(ghalo[tile][g]);
            const float u0 = bflo(mid.x), u1 = bfhi(mid.x), u2 = bflo(mid.y), u3 = bfhi(mid.y);
            const float c0v = tile == 0 ? acc0[4 * g + 0] : tile == 1 ? acc1[4 * g + 0] : tile == 2 ? acc2[4 * g + 0] : acc3[4 * g + 0];
            const float c1v = tile == 0 ? acc0[4 * g + 1] : tile == 1 ? acc1[4 * g + 1] : tile == 2 ? acc2[4 * g + 1] : acc3[4 * g + 1];
            const float c2v = tile == 0 ? acc0[4 * g + 2] : tile == 1 ? acc1[4 * g + 2] : tile == 2 ? acc2[4 * g + 2] : acc3[4 * g + 2];
            const float c3v = tile == 0 ? acc0[4 * g + 3] : tile == 1 ? acc1[4 * g + 3] : tile == 2 ? acc2[4 * g + 3] : acc3[4 * g + 3];
            float r[4];
            r[0] = (um1 * w0 + u0 * w1 + u1 * w2 + cb) * c0v;
            r[1] = (u0 * w0 + u1 * w1 + u2 * w2 + cb) * c1v;
            r[2] = (u1 * w0 + u2 * w1 + u3 * w2 + cb) * c2v;
            r[3] = (u2 * w0 + u3 * w1 + up4 * w2 + cb) * c3v;
            v2u o; o.x = pk2(r[0], r[1]); o.y = pk2(r[2], r[3]);
            if (ORDER == 0) *(LAS v2u*)(C.lds + HY_Y1 + b * HY_YROW + 2 * (96 + t0)) = o;
            else *(v2u*)(YAT + ((size_t)c * 8 + b) * 2048 + t0) = o;
        }
    }
}
struct HyPre { v4u u[4]; unsigned short um1[4], up8[4]; v4u taps; };
__device__ __forceinline__ void hyena_prefetch(const Ctx& C, int c, HyPre& P) {
    const bf16* ZT = (const bf16*)(C.ws + WS_ZT); const bf16* GT = (const bf16*)(C.ws + WS_GTAB);
#pragma unroll
    for (int k = 0; k < 4; ++k) {
        const int ci = C.tid + 512 * k, b = ci >> 8, t0 = (ci & 255) * 8;
        const bf16* u = ZT + ((size_t)b * 1536 + c) * 2048;
        P.u[k] = *(const v4u*)(u + t0); { const unsigned short x = u[t0 > 0 ? t0 - 1 : 0], y = u[t0 + 8 < L ? t0 + 8 : L - 1]; P.um1[k] = (t0 > 0) ? x : (unsigned short)0; P.up8[k] = (t0 + 8 < L) ? y : (unsigned short)0; }
    }
    P.taps = *(const v4u*)(GT + ((size_t)c * 2 + 0) * GT_LEN + C.tid * 8);
}
__device__ __forceinline__ void hyena_taps_fill(const Ctx& C, v4u traw) {
    LAS unsigned char* tmp = C.lds + HY_TMP;
    *(LAS v4u*)(tmp + C.tid * 16) = traw;
    if (C.tid == 0) *(LAS v4u*)(tmp + 8192) = (v4u){0u, 0u, 0u, 0u};
    LDS_BARRIER();
    const v4u hi = *(const LAS v4u*)(tmp + C.tid * 16 + 16);
    const unsigned d[8] = {traw.x, traw.y, traw.z, traw.w, hi.x, hi.y, hi.z, hi.w};
#pragma unroll
    for (int m = 0; m < 8; ++m) {
        v4u w;
        if (m & 1) { w.x = __builtin_amdgcn_alignbit(d[(m >> 1) + 1], d[(m >> 1)], 16); w.y = __builtin_amdgcn_alignbit(d[(m >> 1) + 2], d[(m >> 1) + 1], 16);
                     w.z = __builtin_amdgcn_alignbit(d[(m >> 1) + 3], d[(m >> 1) + 2], 16); w.w = __builtin_amdgcn_alignbit(d[(m >> 1) + 4], d[(m >> 1) + 3], 16); }
        else { w.x = d[m >> 1]; w.y = d[(m >> 1) + 1]; w.z = d[(m >> 1) + 2]; w.w = d[(m >> 1) + 3]; }
        *(LAS v4u*)(C.lds + HY_TAP + m * HY_CS + C.tid * 16) = w;
    }
    LDS_BARRIER();
}
__device__ __forceinline__ void hyena_fast(const Ctx& C, int c, int cnext, ConvSlice& cq) {
    HyPre P; hyena_prefetch(C, c, P);
    const bf16* GT = (const bf16*)(C.ws + WS_GTAB);
    const float* cw = C.in[IN_CONVW]; const float* cbp = C.in[IN_CONVB];
    LDS_BARRIER();
    {
        const float w0 = cw[c], w1 = cw[1536 + c], w2 = cw[3072 + c], cb = cbp[c];
#pragma unroll
        for (int k = 0; k < 4; ++k) {
            const int ci = C.tid + 512 * k, b = ci >> 8, t0 = (ci & 255) * 8;
            float f[10]; unpack8(P.u[k], f + 1);
            f[0] = bf2f(P.um1[k]); f[9] = bf2f(P.up8[k]);
            float o[8];
#pragma unroll
            for (int j = 0; j < 8; ++j) o[j] = f[j] * w0 + f[j + 1] * w1 + f[j + 2] * w2 + cb;
            *(LAS v4u*)(C.lds + HY_Y0 + b * HY_YROW + 2 * (96 + t0)) = pack8(o);
        }
    }
    const v4u t1raw = *(const v4u*)(GT + ((size_t)c * 2 + 1) * GT_LEN + C.tid * 8);
    if (!(C.sub & 32)) hyena_taps_fill(C, P.taps);
    hyena_conv<0>(C, c, cq);
    LDS_BARRIER();
    if (!(C.sub & 32)) hyena_taps_fill(C, t1raw);
    hyena_conv<1>(C, c, cq);
}
__device__ __forceinline__ void hyena_zero_pads(const Ctx& C) {
    for (int i = C.tid; i < 2 * 8 * 100; i += NT) {
        const int buf = i / 800, r = (i % 800) / 100, k = i % 100;
        const int e = (k < 48) ? 2 * k : 2144 + 2 * (k - 48);
        *(LAS unsigned*)(C.lds + (buf ? HY_Y1 : HY_Y0) + r * HY_YROW + 2 * e) = 0u;
    }
    __syncthreads();
}

__device__ __forceinline__ void attn_naive(const Ctx& C, int item) {
    const int b = item >> 5, kvh = (item >> 4) & 1, qb = item & 15;
    const bf16* Q = (const bf16*)(C.ws + WS_QRAW); const bf16* Kr = (const bf16*)(C.ws + WS_KRAW); const bf16* V = (const bf16*)(C.ws + WS_VB);
    const bf16* KC = (const bf16*)(C.ws + WS_KC); const bf16* VC = (const bf16*)(C.ws + WS_VC); bf16* YB = (bf16*)(C.ws + WS_YB);
    const float* rope = (const float*)(C.ws + WS_ROPE);
    LAS float* Ks = (LAS float*)C.lds;
    LAS float* Vs = Ks + 128 * 64;
    const int g = C.tid >> 7, qi = C.tid & 127, h = kvh * 4 + g, t = qb * 128 + qi;
    float q[64];
    {
        const bf16* qr = Q + ((size_t)b * L + t) * QW + h * 64; float ss = 0.f;
#pragma unroll
        for (int j = 0; j < 8; ++j) { unpack8(*(const v4u*)(qr + 8 * j), q + 8 * j); }
#pragma unroll
        for (int d = 0; d < 64; ++d) ss += q[d] * q[d];
        const float rs = 1.f / sqrtf(ss * (1.f / 64.f) + EPS);
#pragma unroll
        for (int i = 0; i < 32; ++i) { const float cs = rope[((size_t)t * 32 + i) * 2], sn = rope[((size_t)t * 32 + i) * 2 + 1];
            const float xe = q[2 * i] * rs * C.in[IN_QNORM][2 * i], xo = q[2 * i + 1] * rs * C.in[IN_QNORM][2 * i + 1];
            q[2 * i] = rbf((xe * cs - xo * sn) * 0.125f); q[2 * i + 1] = rbf((xe * sn + xo * cs) * 0.125f); }
    }
    float mrun = -1e30f, lrun = 0.f, o[64];
#pragma unroll
    for (int d = 0; d < 64; ++d) o[d] = 0.f;
    for (int ch = 0; ch < 5; ++ch) {
        const int kblk = qb - 1 + ch;
        if (ch < 3 && (kblk < 0 || kblk >= 16)) continue;
        __syncthreads();
        {
            const int key = C.tid >> 2, part = C.tid & 3;
            const bf16* kr; const bf16* vr; int pos = 0;
            if (ch < 3) { pos = kblk * 128 + key; kr = Kr + ((size_t)b * L + pos) * KVW + kvh * 64 + part * 16; vr = V + ((size_t)b * L + pos) * KVW + kvh * 64 + part * 16; }
            else { const int cp = (ch - 3) * 128 + key; kr = KC + ((size_t)b * LC + cp) * KVW + kvh * 64 + part * 16; vr = VC + ((size_t)b * LC + cp) * KVW + kvh * 64 + part * 16; }
            float kf[16], vf[16];
            unpack8(*(const v4u*)kr, kf); unpack8(*(const v4u*)(kr + 8), kf + 8); unpack8(*(const v4u*)vr, vf); unpack8(*(const v4u*)(vr + 8), vf + 8);
            float ss = 0.f;
#pragma unroll
            for (int d = 0; d < 16; ++d) ss += kf[d] * kf[d];
            ss += __shfl_xor(ss, 1); ss += __shfl_xor(ss, 2);
            const float rs = 1.f / sqrtf(ss * (1.f / 64.f) + EPS);
#pragma unroll
            for (int i = 0; i < 8; ++i) {
                const int pi = part * 8 + i;
                float xe = kf[2 * i] * rs * C.in[IN_KNORM][2 * pi], xo = kf[2 * i + 1] * rs * C.in[IN_KNORM][2 * pi + 1];
                if (ch < 3) { const float cs = rope[((size_t)pos * 32 + pi) * 2], sn = rope[((size_t)pos * 32 + pi) * 2 + 1]; const float a = xe * cs - xo * sn, bb = xe * sn + xo * cs; xe = a; xo = bb; }
                Ks[key * 64 + part * 16 + 2 * i] = rbf(xe); Ks[key * 64 + part * 16 + 2 * i + 1] = rbf(xo);
            }
#pragma unroll
            for (int d = 0; d < 16; ++d) Vs[key * 64 + part * 16 + d] = vf[d];
        }
        __syncthreads();
        for (int key = 0; key < 128; ++key) {
            if (ch < 3) { const int s = kblk * 128 + key; const int df = t - s; if (df > 128 || df < -128) continue; }
            float sc = 0.f;
#pragma unroll
            for (int d = 0; d < 64; ++d) sc += q[d] * Ks[key * 64 + d];
            const float mn = fmaxf(mrun, sc), al = __expf(mrun - mn), p = __expf(sc - mn);
            lrun = lrun * al + p; mrun = mn;
#pragma unroll
            for (int d = 0; d < 64; ++d) o[d] = o[d] * al + p * Vs[key * 64 + d];
        }
    }
    {
        const float sk = C.in[IN_SINK][h]; const float mn = fmaxf(mrun, sk), al = __expf(mrun - mn);
        lrun = lrun * al + __expf(sk - mn); const float inv = al / lrun;
        bf16* yr = YB + ((size_t)b * L + t) * QW + h * 64;
#pragma unroll
        for (int j = 0; j < 8; ++j) { float v[8];
#pragma unroll
            for (int d = 0; d < 8; ++d) v[d] = o[8 * j + d] * inv;
            *(v4u*)(yr + 8 * j) = pack8(v); }
    }
}


__device__ __forceinline__ void ya_transpose(const Ctx& C) {
    const bf16* YAT = (const bf16*)(C.ws + WS_YAT); bf16* YA = (bf16*)(C.ws + WS_YA);
    constexpr int RS = 144;
    for (int blk = C.bid; blk < M / 64; blk += C.nb) {
        const int tok0 = blk * 64, b = tok0 >> 11, t0 = tok0 & 2047;
        __syncthreads();
#pragma unroll
        for (int p = 0; p < 8; ++p) { const int c = (C.tid >> 3) + 64 * p, seg = C.tid & 7;
            *(LAS v4u*)(C.lds + c * RS + seg * 16) = *(const v4u*)(YAT + ((size_t)c * 8 + b) * 2048 + t0 + 8 * seg); }
        __syncthreads();
#pragma unroll 2
        for (int k = 0; k < 8; ++k) { const int tt = C.wave + 8 * k; unsigned e[8];
#pragma unroll
            for (int j = 0; j < 8; ++j) e[j] = *(const LAS bf16*)(C.lds + (8 * C.lane + j) * RS + tt * 2);
            v4u w; w.x = e[0] | (e[1] << 16); w.y = e[2] | (e[3] << 16); w.z = e[4] | (e[5] << 16); w.w = e[6] | (e[7] << 16);
            *(v4u*)(YA + (size_t)(tok0 + tt) * HW + 8 * C.lane) = w; }
    }
}

constexpr int AT_KS = 0, AT_KROW = 144, AT_VT = 128 * 144, AT_VROW = 192;
__device__ __forceinline__ void attn_fast(const Ctx& C, int item) {
    const int b = item >> 5, kvh = (item >> 4) & 1, qb = item & 15;
    const bf16* Q = (const bf16*)(C.ws + WS_QRAW); const bf16* Kr = (const bf16*)(C.ws + WS_KRAW); const bf16* V = (const bf16*)(C.ws + WS_VB);
    const bf16* KC = (const bf16*)(C.ws + WS_KC); const bf16* VC = (const bf16*)(C.ws + WS_VC); bf16* YB = (bf16*)(C.ws + WS_YB);
    const float* rope = (const float*)(C.ws + WS_ROPE);
    const int w = C.wave, g = w >> 1, qh = w & 1, hd = kvh * 4 + g, lane = C.lane, q = lane & 31, h = lane >> 5;
    bf16x8 qf[2][4];
#pragma unroll
    for (int qt = 0; qt < 2; ++qt) {
        const int t = qb * 128 + qh * 64 + qt * 32 + q;
        const bf16* qr = Q + ((size_t)b * L + t) * QW + hd * 64;
        float x[32]; float ss = 0.f;
#pragma unroll
        for (int ks = 0; ks < 4; ++ks) unpack8(*(const v4u*)(qr + 16 * ks + 8 * h), x + 8 * ks);
#pragma unroll
        for (int i = 0; i < 32; ++i) ss += x[i] * x[i];
        ss += __shfl_xor(ss, 32);
        const float rs = 1.f / sqrtf(ss * (1.f / 64.f) + EPS);
#pragma unroll
        for (int ks = 0; ks < 4; ++ks) {
            unsigned wv[4];
#pragma unroll
            for (int jp = 0; jp < 4; ++jp) {
                const int dim = 16 * ks + 8 * h + 2 * jp, pi = dim >> 1;
                const f32x2_t cs = *(const f32x2_t*)(rope + ((size_t)t * 32 + pi) * 2);
                const float xe = x[8 * ks + 2 * jp] * rs * C.in[IN_QNORM][dim], xo = x[8 * ks + 2 * jp + 1] * rs * C.in[IN_QNORM][dim + 1];
                wv[jp] = cvtpk((xe * cs.x - xo * cs.y) * (0.125f * 1.4426950408889634f), (xe * cs.y + xo * cs.x) * (0.125f * 1.4426950408889634f));
            }
            v4u pk; pk.x = wv[0]; pk.y = wv[1]; pk.z = wv[2]; pk.w = wv[3];
            qf[qt][ks] = __builtin_bit_cast(bf16x8, pk);
        }
    }
    f32x16 O00, O01, O10, O11;
#pragma unroll
    for (int i = 0; i < 16; ++i) { O00[i] = 0.f; O01[i] = 0.f; O10[i] = 0.f; O11[i] = 0.f; }
    float mrun0 = -1e30f, mrun1 = -1e30f, lrun0 = 0.f, lrun1 = 0.f;
    const int skey = C.tid >> 2, spart = C.tid & 3;
    v4u rk0, rk1, rv0, rv1;
#define AT_CH(cc_) (((cc_) == 0) ? 1 : ((cc_) == 1 ? 0 : (cc_)))
#define AT_VALID(cc_) (!(AT_CH(cc_) < 3 && (qb - 1 + AT_CH(cc_) < 0 || qb - 1 + AT_CH(cc_) >= 16)))
#define AT_LOAD(cc_) do { const int ch_ = AT_CH(cc_); const bf16* kr_; const bf16* vr_; \
        if (ch_ < 3) { const int pos_ = (qb - 1 + ch_) * 128 + skey; kr_ = Kr + ((size_t)b * L + pos_) * KVW + kvh * 64 + spart * 16; vr_ = V + ((size_t)b * L + pos_) * KVW + kvh * 64 + spart * 16; } \
        else { const int cp_ = (ch_ - 3) * 128 + skey; kr_ = KC + ((size_t)b * LC + cp_) * KVW + kvh * 64 + spart * 16; vr_ = VC + ((size_t)b * LC + cp_) * KVW + kvh * 64 + spart * 16; } \
        rk0 = *(const v4u*)kr_; rk1 = *(const v4u*)(kr_ + 8); rv0 = *(const v4u*)vr_; rv1 = *(const v4u*)(vr_ + 8); } while (0)
    AT_LOAD(0);
    for (int cc = 0; cc < 5; ++cc) {
        const int ch = AT_CH(cc);
        const int kblk = qb - 1 + ch;
        if (!AT_VALID(cc)) continue;
        LDS_BARRIER();
        {
            const int key = skey, part = spart; const int pos = kblk * 128 + key;
            float kf[16];
            const v4u v0 = rv0, v1 = rv1;
            unpack8(rk0, kf); unpack8(rk1, kf + 8);
            float ss = 0.f;
#pragma unroll
            for (int d = 0; d < 16; ++d) ss += kf[d] * kf[d];
            ss += __shfl_xor(ss, 1); ss += __shfl_xor(ss, 2);
            const float rs = 1.f / sqrtf(ss * (1.f / 64.f) + EPS);
            unsigned wv[8];
#pragma unroll
            for (int i = 0; i < 8; ++i) {
                const int pi = part * 8 + i;
                float xe = kf[2 * i] * rs * C.in[IN_KNORM][2 * pi], xo = kf[2 * i + 1] * rs * C.in[IN_KNORM][2 * pi + 1];
                if (ch < 3) { const f32x2_t cs = *(const f32x2_t*)(rope + ((size_t)pos * 32 + pi) * 2); const float a = xe * cs.x - xo * cs.y, bb = xe * cs.y + xo * cs.x; xe = a; xo = bb; }
                wv[i] = cvtpk(xe, xo);
            }
            v4u k0; k0.x = wv[0]; k0.y = wv[1]; k0.z = wv[2]; k0.w = wv[3];
            v4u k1; k1.x = wv[4]; k1.y = wv[5]; k1.z = wv[6]; k1.w = wv[7];
            *(LAS v4u*)(C.lds + AT_KS + key * AT_KROW + part * 32) = k0; *(LAS v4u*)(C.lds + AT_KS + key * AT_KROW + part * 32 + 16) = k1;
            *(LAS v4u*)(C.lds + AT_VT + key * AT_VROW + part * 32) = v0; *(LAS v4u*)(C.lds + AT_VT + key * AT_VROW + part * 32 + 16) = v1;
        }
        {
            int nc = cc + 1; while (nc < 5 && !AT_VALID(nc)) ++nc;
            if (nc < 5) AT_LOAD(nc);
        }
        LDS_BARRIER();
#pragma unroll 1
        for (int kt = 0; kt < 4; ++kt) {
            const bool sk0 = (ch == 0) ? (2 * qh + 0 > kt) : (ch == 2 ? (kt > 2 * qh + 0) : false);
            const bool sk1 = (ch == 0) ? (2 * qh + 1 > kt) : (ch == 2 ? (kt > 2 * qh + 1) : false);
            if (sk0 && sk1) continue;
            bf16x8 kfr[4];
#pragma unroll
            for (int ks = 0; ks < 4; ++ks) kfr[ks] = *(const LAS bf16x8*)(C.lds + AT_KS + (kt * 32 + q) * AT_KROW + ks * 32 + h * 16);
            bf16x8 vfr[2][2];
#pragma unroll
            for (int dt = 0; dt < 2; ++dt)
#pragma unroll
                for (int sI = 0; sI < 2; ++sI) {
                    typedef short v4i16_t __attribute__((ext_vector_type(4)));
                    const LAS unsigned char* vp = C.lds + AT_VT + (kt * 32 + 16 * sI + 4 * h + ((lane & 15) >> 2)) * AT_VROW + (dt * 32 + 16 * ((lane >> 4) & 1) + 4 * (lane & 3)) * 2;
                    const v4i16_t lo = __builtin_amdgcn_ds_read_tr16_b64_v4i16((LAS v4i16_t*)vp), hi2 = __builtin_amdgcn_ds_read_tr16_b64_v4i16((LAS v4i16_t*)(vp + 8 * AT_VROW));
                    vfr[dt][sI] = __builtin_shufflevector(lo, hi2, 0, 1, 2, 3, 4, 5, 6, 7);
                }
#pragma unroll
            for (int qt = 0; qt < 2; ++qt) {
                if (qt == 0 ? sk0 : sk1) continue;
                f32x16 sT;
#pragma unroll
                for (int i = 0; i < 16; ++i) sT[i] = 0.f;
#pragma unroll
                for (int ks = 0; ks < 4; ++ks) sT = __builtin_amdgcn_mfma_f32_32x32x16_bf16(kfr[ks], qf[qt][ks], sT, 0, 0, 0);
                if (ch == 0 || ch == 2) {
                    const int tq = qb * 128 + qh * 64 + qt * 32 + q;
#pragma unroll
                    for (int r = 0; r < 16; ++r) { const int sp = kblk * 128 + kt * 32 + (r & 3) + 8 * (r >> 2) + 4 * h; const int df = tq - sp; if (df > 128 || df < -128) sT[r] = -1e30f; }
                }
                float mx = sT[0];
#pragma unroll
                for (int r = 1; r < 16; ++r) mx = fmaxf(mx, sT[r]);
                mx = fmaxf(mx, __shfl_xor(mx, 32));
                const float mo = qt ? mrun1 : mrun0; const float mn = fmaxf(mo, mx), al = __builtin_amdgcn_exp2f(mo - mn);
                float rsum = 0.f; float pv[16];
#pragma unroll
                for (int r = 0; r < 16; ++r) { pv[r] = __builtin_amdgcn_exp2f(sT[r] - mn); rsum += pv[r]; }
                v4u p0, p1;
                p0.x = cvtpk(pv[0], pv[1]); p0.y = cvtpk(pv[2], pv[3]); p0.z = cvtpk(pv[4], pv[5]); p0.w = cvtpk(pv[6], pv[7]);
                p1.x = cvtpk(pv[8], pv[9]); p1.y = cvtpk(pv[10], pv[11]); p1.z = cvtpk(pv[12], pv[13]); p1.w = cvtpk(pv[14], pv[15]);
                const bf16x8 pf0 = __builtin_bit_cast(bf16x8, p0), pf1 = __builtin_bit_cast(bf16x8, p1);
                const bool grew = __any(mn > mo);
                if (qt == 0) {
                    mrun0 = mn; lrun0 = lrun0 * al + rsum;
                    if (grew) {
#pragma unroll
                    for (int i = 0; i < 16; ++i) { O00[i] *= al; O01[i] *= al; } }
                    O00 = __builtin_amdgcn_mfma_f32_32x32x16_bf16(vfr[0][0], pf0, O00, 0, 0, 0); O00 = __builtin_amdgcn_mfma_f32_32x32x16_bf16(vfr[0][1], pf1, O00, 0, 0, 0);
                    O01 = __builtin_amdgcn_mfma_f32_32x32x16_bf16(vfr[1][0], pf0, O01, 0, 0, 0); O01 = __builtin_amdgcn_mfma_f32_32x32x16_bf16(vfr[1][1], pf1, O01, 0, 0, 0);
                } else {
                    mrun1 = mn; lrun1 = lrun1 * al + rsum;
                    if (grew) {
#pragma unroll
                    for (int i = 0; i < 16; ++i) { O10[i] *= al; O11[i] *= al; } }
                    O10 = __builtin_amdgcn_mfma_f32_32x32x16_bf16(vfr[0][0], pf0, O10, 0, 0, 0); O10 = __builtin_amdgcn_mfma_f32_32x32x16_bf16(vfr[0][1], pf1, O10, 0, 0, 0);
                    O11 = __builtin_amdgcn_mfma_f32_32x32x16_bf16(vfr[1][0], pf0, O11, 0, 0, 0); O11 = __builtin_amdgcn_mfma_f32_32x32x16_bf16(vfr[1][1], pf1, O11, 0, 0, 0);
                }
            }
        }
    }
#undef AT_CH
#undef AT_VALID
#undef AT_LOAD
    const float sk = C.in[IN_SINK][hd] * 1.4426950408889634f;
#pragma unroll
    for (int qt = 0; qt < 2; ++qt) {
        const float mo = qt ? mrun1 : mrun0; float l = qt ? lrun1 : lrun0; l += __shfl_xor(l, 32);
        const float mn = fmaxf(mo, sk), al = __builtin_amdgcn_exp2f(mo - mn); l = l * al + __builtin_amdgcn_exp2f(sk - mn);
        const float inv = al / l;
        const int t = qb * 128 + qh * 64 + qt * 32 + q;
        bf16* yr = YB + ((size_t)b * L + t) * QW + hd * 64;
#pragma unroll
        for (int dt = 0; dt < 2; ++dt)
#pragma unroll
            for (int gq = 0; gq < 4; ++gq) {
                float v[4];
#pragma unroll
                for (int i = 0; i < 4; ++i) v[i] = (qt ? (dt ? O11[4 * gq + i] : O10[4 * gq + i]) : (dt ? O01[4 * gq + i] : O00[4 * gq + i])) * inv;
                v2u o; o.x = cvtpk(v[0], v[1]); o.y = cvtpk(v[2], v[3]);
                *(v2u*)(yr + dt * 32 + 8 * gq + 4 * h) = o;
            }
    }
}

__device__ __forceinline__ void p7_phase(const Ctx& C) {
    const float* UPART = (const float*)(C.ws + WS_UPART); const float* SSQP = (const float*)(C.ws + WS_SSQP); const float* CB = (const float*)(C.ws + WS_CB);
    const float* mod = (const float*)(C.ws + WS_MOD); const bf16* XN = (const bf16*)(C.ws + WS_XNEW);
    int* SLOT = (int*)(C.ws + WS_SLOT); float* SELG = (float*)(C.ws + WS_SELG); unsigned char* XIN = (unsigned char*)(C.ws + WS_XIN);
    LAS unsigned long long* KY = (LAS unsigned long long*)C.lds;
    LAS int* rk = (LAS int*)(C.lds + 16384);
    LAS float* RSTD = (LAS float*)(C.lds + 24576);
    LAS float* GM = (LAS float*)(C.lds + 32768);
    LAS float* BB = (LAS float*)(C.lds + 36864);
    ConvSlice kq = conv_slice(C, TR_TK0, 2);
    for (int it = C.bid; it < NB * NE * 2; it += C.nb) {
        const int b = it & 7, half = (it >> 3) & 1, e = (it >> 4) & 15;
        __syncthreads();
        for (int i = C.tid; i < D; i += NT) { GM[i] = C.in[IN_NORM2][i] * (1.f + mod[(size_t)b * MODW + 4 * D + i]); BB[i] = mod[(size_t)b * MODW + 3 * D + i]; }
        float cb[16];
#pragma unroll
        for (int i = 0; i < 16; ++i) cb[i] = CB[b * 16 + i];
        for (int t = C.tid; t < L; t += NT) {
            const size_t row = (size_t)b * L + t;
            f32x4 u[4][4]; float sq[4];
#pragma unroll
            for (int p = 0; p < 4; ++p) { sq[p] = SSQP[(size_t)p * M + row];
#pragma unroll
                for (int q = 0; q < 4; ++q) u[p][q] = *(const f32x4*)(UPART + ((size_t)p * M + row) * 16 + 4 * q); }
            __builtin_amdgcn_sched_barrier(0);
            const float ssq = (sq[0] + sq[1]) + (sq[2] + sq[3]);
            const float rstd = 1.f / sqrtf(ssq * (1.f / D) + EPS);
            float lg[16];
#pragma unroll
            for (int q = 0; q < 4; ++q)
#pragma unroll
                for (int i = 0; i < 4; ++i) lg[4 * q + i] = ((u[0][q][i] + u[1][q][i]) + (u[2][q][i] + u[3][q][i])) * rstd + cb[4 * q + i];
            float mx = lg[0];
#pragma unroll
            for (int i = 1; i < 16; ++i) mx = fmaxf(mx, lg[i]);
            float den = 0.f, mine = 0.f;
#pragma unroll
            for (int i = 0; i < 16; ++i) { const float p = expf(lg[i] - mx); den += p; mine = (i == e) ? p : mine; }
            const unsigned bits = __builtin_bit_cast(unsigned, mine / den);
            KY[t] = ~(((unsigned long long)bits << 32) | (unsigned long long)(2047 - t)); rk[t] = -1; RSTD[t] = rstd;
        }
        __syncthreads();
        TrItem Ta, Tb; f32x4 cva[8], cvb[8]; const bool cv = kq.left >= 2;
        if (cv) { tr_item(C, kq.it, Ta); tr_item(C, kq.it + 1, Tb); tr_load(Ta, C.lane, cva); tr_load(Tb, C.lane, cvb); }
        {
            LAS unsigned* HIST = (LAS unsigned*)(C.lds + 40960);
            LAS unsigned* SELW = HIST + 1024;
            LAS unsigned* WCT = SELW + 8;
            LAS unsigned* PRE = WCT + 64;
            unsigned kv[4];
#pragma unroll
            for (int r = 0; r < 4; ++r) kv[r] = (unsigned)((~KY[C.tid + 512 * r]) >> 32);
            HIST[C.tid] = 0u; HIST[C.tid + 512] = 0u;
            LDS_BARRIER();
            unsigned prefix = 0u, need = CAP;
#pragma unroll
            for (int p = 0; p < 4; ++p) {
                const int shift = 24 - 8 * p;
#pragma unroll
                for (int r = 0; r < 4; ++r) { const bool act = (p == 0) || ((kv[r] >> ((shift + 8) & 31)) == prefix);
                    if (act) (void)__hip_atomic_fetch_add(HIST + p * 256 + ((kv[r] >> shift) & 255u), 1u, __ATOMIC_RELAXED, __HIP_MEMORY_SCOPE_WORKGROUP); }
                LDS_BARRIER();
                if (C.wave == 0) {
                    const unsigned c0 = HIST[p * 256 + 4 * C.lane], c1 = HIST[p * 256 + 4 * C.lane + 1], c2 = HIST[p * 256 + 4 * C.lane + 2], c3 = HIST[p * 256 + 4 * C.lane + 3];
                    const unsigned sl = (c0 + c1) + (c2 + c3);
                    unsigned S = sl;
#pragma unroll
                    for (int o = 1; o < 64; o <<= 1) { const unsigned v = (unsigned)__shfl_down((int)S, o); if (C.lane + o < 64) S += v; }
                    const unsigned E = S - sl;
                    if (E < need && need <= S) {
                        unsigned cum = E, B, above;
                        if (cum + c3 >= need) { B = 3u; above = cum; } else { cum += c3;
                        if (cum + c2 >= need) { B = 2u; above = cum; } else { cum += c2;
                        if (cum + c1 >= need) { B = 1u; above = cum; } else { cum += c1; B = 0u; above = cum; } } }
                        SELW[0] = 4u * (unsigned)C.lane + B; SELW[1] = above;
                    }
                }
                LDS_BARRIER();
                prefix = (prefix << 8) | SELW[0]; need -= SELW[1];
            }
            unsigned long long bt[4], be[4];
#pragma unroll
            for (int r = 0; r < 4; ++r) { bt[r] = __ballot(kv[r] > prefix); be[r] = __ballot(kv[r] == prefix);
                if (C.lane == 0) { WCT[r * 8 + C.wave] = (unsigned)__popcll(bt[r]); WCT[32 + r * 8 + C.wave] = (unsigned)__popcll(be[r]); } }
            LDS_BARRIER();
            if (C.wave == 0) {
                const unsigned v = WCT[C.lane]; unsigned inc = v;
#pragma unroll
                for (int o = 1; o < 32; o <<= 1) { const unsigned u = (unsigned)__shfl_up((int)inc, o); if ((C.lane & 31) >= o) inc += u; }
                PRE[C.lane] = inc - v;
            }
            LDS_BARRIER();
            const unsigned long long lt = (1ull << C.lane) - 1ull;
#pragma unroll
            for (int r = 0; r < 4; ++r) {
                const int t = C.tid + 512 * r; int slot = -1;
                if (kv[r] > prefix) slot = (int)(PRE[r * 8 + C.wave] + (unsigned)__popcll(bt[r] & lt));
                else if (kv[r] == prefix) { const unsigned rq = PRE[32 + r * 8 + C.wave] + (unsigned)__popcll(be[r] & lt); if (rq < need) slot = (int)(CAP - need + rq); }
                if (slot >= 0) { rk[t] = slot; KY[slot] = ~(((unsigned long long)kv[r] << 32) | (unsigned long long)(2047 - t)); }
            }
            LDS_BARRIER();
        }
        if (cv) { tr_store(Ta, C.lane, cva); tr_store(Tb, C.lane, cvb); kq.it += 2; kq.left -= 2; }
        if (C.tid < CAP) { const unsigned long long key = ~KY[C.tid]; const int t = 2047 - (int)(unsigned)(key & 0xffffffffull); rk[t] = C.tid;
            if (half == 0) SELG[e * 2048 + b * 256 + C.tid] = __builtin_bit_cast(float, (unsigned)(key >> 32)); }
        __syncthreads();
        for (int t = half * (L / 2) + C.tid; t < (half + 1) * (L / 2); t += NT) SLOT[((size_t)b * L + t) * 16 + e] = rk[t];
        const f32x4 g0 = *(const LAS f32x4*)(GM + 16 * C.lane), g1 = *(const LAS f32x4*)(GM + 16 * C.lane + 4), g2 = *(const LAS f32x4*)(GM + 16 * C.lane + 8), g3 = *(const LAS f32x4*)(GM + 16 * C.lane + 12);
        const f32x4 b0 = *(const LAS f32x4*)(BB + 16 * C.lane), b1 = *(const LAS f32x4*)(BB + 16 * C.lane + 4), b2 = *(const LAS f32x4*)(BB + 16 * C.lane + 8), b3 = *(const LAS f32x4*)(BB + 16 * C.lane + 12);
        for (int r0 = half * 128 + C.wave * 16; r0 < half * 128 + C.wave * 16 + 16; r0 += 4) {
            v4u xw[4][2]; float rs[4];
#pragma unroll
            for (int k = 0; k < 4; ++k) { const int t = 2047 - (int)(unsigned)((~KY[r0 + k]) & 0xffffffffull); rs[k] = RSTD[t];
                const bf16* xr = XN + ((size_t)b * L + t) * D + 16 * C.lane;
                xw[k][0] = *(const v4u*)xr; xw[k][1] = *(const v4u*)(xr + 8); }
#pragma unroll
            for (int k = 0; k < 4; ++k) {
                float xf[16]; unpack8(xw[k][0], xf); unpack8(xw[k][1], xf + 8);
                const f32x4 x[1][4] = {{{xf[0], xf[1], xf[2], xf[3]}, {xf[4], xf[5], xf[6], xf[7]}, {xf[8], xf[9], xf[10], xf[11]}, {xf[12], xf[13], xf[14], xf[15]}}};
                v4u w;
                w.x = pk4_fp8(x[0][0][0] * rs[k] * g0[0] + b0[0], x[0][0][1] * rs[k] * g0[1] + b0[1], x[0][0][2] * rs[k] * g0[2] + b0[2], x[0][0][3] * rs[k] * g0[3] + b0[3]);
                w.y = pk4_fp8(x[0][1][0] * rs[k] * g1[0] + b1[0], x[0][1][1] * rs[k] * g1[1] + b1[1], x[0][1][2] * rs[k] * g1[2] + b1[2], x[0][1][3] * rs[k] * g1[3] + b1[3]);
                w.z = pk4_fp8(x[0][2][0] * rs[k] * g2[0] + b2[0], x[0][2][1] * rs[k] * g2[1] + b2[1], x[0][2][2] * rs[k] * g2[2] + b2[2], x[0][2][3] * rs[k] * g2[3] + b2[3]);
                w.w = pk4_fp8(x[0][3][0] * rs[k] * g3[0] + b3[0], x[0][3][1] * rs[k] * g3[1] + b3[1], x[0][3][2] * rs[k] * g3[2] + b3[2], x[0][3][3] * rs[k] * g3[3] + b3[3]);
                *((v4u*)(XIN + ((size_t)e * 2048 + b * 256 + r0 + k) * D) + C.lane) = w;
            }
        }
    }
    conv_flush(C, kq);
}

__device__ __forceinline__ void p10_row(const Ctx& C, int row, int sv, unsigned long long mask, const f32x4 (&xin)[4]) {
    const int lane = C.lane, b = row >> 11; const unsigned char* Y = (const unsigned char*)(C.ws + WS_YBUF);
    float* o = C.out + (size_t)row * D + 16 * lane;
    f32x4 acc[4] = {xin[0], xin[1], xin[2], xin[3]};
    while (mask) {
        int ee[4]; float wgt[4];
        const int e0 = __builtin_ctzll(mask);
#pragma unroll
        for (int k = 0; k < 4; ++k) { if (mask) { ee[k] = __builtin_ctzll(mask); mask &= mask - 1; wgt[k] = 1.f / 32.f; } else { ee[k] = e0; wgt[k] = 0.f; } }
        v4u y[4];
#pragma unroll
        for (int k = 0; k < 4; ++k) { const int sl = __builtin_amdgcn_readlane(sv, ee[k]); y[k] = *((const v4u*)(Y + ((size_t)ee[k] * 2048 + b * 256 + sl) * D) + lane); }
        __builtin_amdgcn_sched_barrier(0);
#pragma unroll
        for (int k = 0; k < 4; ++k) {
            const unsigned w[4] = {y[k].x, y[k].y, y[k].z, y[k].w};
#pragma unroll
            for (int q = 0; q < 4; ++q) { const f32x2_t lo = __builtin_amdgcn_cvt_pk_f32_fp8((int)w[q], false), hi = __builtin_amdgcn_cvt_pk_f32_fp8((int)w[q], true);
                acc[q][0] += wgt[k] * lo.x; acc[q][1] += wgt[k] * lo.y; acc[q][2] += wgt[k] * hi.x; acc[q][3] += wgt[k] * hi.y; }
        }
    }
#pragma unroll
    for (int q = 0; q < 4; ++q) *(f32x4*)(o + 4 * q) = acc[q];
}
__device__ __forceinline__ void p10_phase(const Ctx& C) {
    const int gw = C.bid * NWAVES + C.wave, NGW = C.nb * NWAVES, lane = C.lane;
    const int* SLOT = (const int*)(C.ws + WS_SLOT); const bf16* XN = (const bf16*)(C.ws + WS_XNEW);
    for (int row = gw * 2; row < M; row += NGW * 2) {
        const int sv0 = SLOT[(size_t)row * 16 + (lane & 15)], sv1 = SLOT[(size_t)(row + 1) * 16 + (lane & 15)];
        f32x4 x0[4], x1[4];
        { const bf16* xi = XN + (size_t)row * D + 16 * lane;
          const v4u a0 = *(const v4u*)xi, a1 = *(const v4u*)(xi + 8), c0 = *(const v4u*)(xi + D), c1 = *(const v4u*)(xi + D + 8);
          float fa[16], fc[16]; unpack8(a0, fa); unpack8(a1, fa + 8); unpack8(c0, fc); unpack8(c1, fc + 8);
#pragma unroll
          for (int q = 0; q < 4; ++q) { x0[q] = (f32x4){fa[4 * q], fa[4 * q + 1], fa[4 * q + 2], fa[4 * q + 3]}; x1[q] = (f32x4){fc[4 * q], fc[4 * q + 1], fc[4 * q + 2], fc[4 * q + 3]}; } }
        const unsigned long long m0 = __ballot(sv0 >= 0) & 0xffffull, m1 = __ballot(sv1 >= 0) & 0xffffull;
        p10_row(C, row, sv0, m0, x0); p10_row(C, row + 1, sv1, m1, x1);
    }
}

__global__ void __launch_bounds__(NT, 2) mk_fwd(Args args) {
    extern __shared__ __attribute__((aligned(16))) unsigned char lds_raw[];
    Ctx C;
    C.lds = (LAS unsigned char*)lds_raw; C.tid = threadIdx.x; C.lane = C.tid & 63; C.wave = __builtin_amdgcn_readfirstlane(C.tid >> 6);
    C.bid = blockIdx.x; C.nb = gridDim.x; C.out = args.out; C.ws = args.ws; C.sub = args.sub;
#pragma unroll
    for (int i = 0; i < 30; ++i) C.in[i] = args.in[i];
    volatile LAS unsigned* MISC = (volatile LAS unsigned*)(C.lds + MISC_OFF);
    if (C.tid < 32) MISC[C.tid] = 0u;
    __syncthreads();
    unsigned* ctl = (unsigned*)(C.ws + WS_CTL);
    XcdBarrier bar; bar.bar = ctl + CW_BAR + args.li * XCD_BAR_WORDS; bar.x = 0; bar.st = nullptr;
    if (N_LAUNCHES != NPH) bar = xcd_barrier_post(ctl + CW_BAR + args.li * XCD_BAR_WORDS, MISC + 8);
    const int lo = args.ph_lo, hi = args.ph_hi;
#ifndef PH_MASK
#define PH_MASK 0xfff
#endif
#define IN(k) (((PH_MASK >> (k)) & 1) && lo <= (k) && (k) < hi)
#define SEAM(k) do { if (IN(k) && IN((k) + 1)) xcd_barrier(bar); } while (0)
    unsigned char* ws = C.ws;
    if (IN(0)) { p0_phase(C); } if (C.nb != 256) SEAM(0);
    if (IN(1)) { p1_phase(C); } SEAM(1);
    if (IN(2)) {
        pg8::SchedIn S{(const char*)(ws + WS_HX), (const char*)(ws + WS_WINT), C.nb, C.bid};
        EpiInB E{(bf16*)(ws + WS_ZT), (bf16*)(ws + WS_QRAW), (bf16*)(ws + WS_KRAW), (bf16*)(ws + WS_VB), (bf16*)(ws + WS_KC), (bf16*)(ws + WS_VC)};
        pg8::gemm_phase(C.lds, D, S, E);
        { pg8::SchedGate S8{(const char*)(ws + WS_HX8), (const char*)(ws + WS_WG8), C.nb, C.bid};
          EpiGate E8{(unsigned char*)(ws + WS_GA), (unsigned char*)(ws + WS_GB)};
          pg8::gemm_phase<EpiGate, pg8::SchedGate, true>(C.lds, D / 2, S8, E8); }
        if (C.nb == 256 && C.bid >= 144) {
            TrItem Ta, Tb; f32x4 va[8], vb[8]; const int w0 = TR_NITEMS - TR_TAIL + ((C.bid - 144) * NWAVES + C.wave) * 4;
#pragma unroll 1
            for (int r = 0; r < 2; ++r) { tr_item(C, w0 + 2 * r, Ta); tr_item(C, w0 + 2 * r + 1, Tb); tr_load(Ta, C.lane, va); tr_load(Tb, C.lane, vb); tr_store(Ta, C.lane, va); tr_store(Tb, C.lane, vb); }
        }
    } SEAM(2);
    if (IN(3)) {
        if (C.nb == 256) { tap_table(C); asm volatile("s_waitcnt vmcnt(0)" ::: "memory"); __syncthreads(); }
        const bool attn_first = ((C.bid >> 3) & 1) != 0;
        if (attn_first) {
            if ((args.sub & 3) != 1) for (int it = C.bid; it < NB * 2 * 16; it += C.nb) attn_fast(C, it);
            __syncthreads();
            ConvSlice cq = conv_slice_hy(C);
            if ((args.sub & 3) != 2) { hyena_zero_pads(C);
                for (int c = C.bid; c < HW; c += C.nb) hyena_fast(C, c, (c + C.nb < HW) ? c + C.nb : -1, cq); }
            conv_flush(C, cq);
        } else {
            ConvSlice cq = conv_slice_hy(C);
            if ((args.sub & 3) != 2) { hyena_zero_pads(C);
                for (int c = C.bid; c < HW; c += C.nb) hyena_fast(C, c, (c + C.nb < HW) ? c + C.nb : -1, cq); }
            conv_flush(C, cq);
            __syncthreads();
            if ((args.sub & 3) != 1) for (int it = C.bid; it < NB * 2 * 16; it += C.nb) attn_fast(C, it);
            if (C.nb == 256) {
                TrItem Ta, Tb; f32x4 va[8], vb[8]; const int w0 = TR_AT0 + (((((C.bid >> 4) << 3) | (C.bid & 7)) * NWAVES) + C.wave) * 4;
#pragma unroll 1
                for (int r = 0; r < 2; ++r) { tr_item(C, w0 + 2 * r, Ta); tr_item(C, w0 + 2 * r + 1, Tb); tr_load(Ta, C.lane, va); tr_load(Tb, C.lane, vb); tr_store(Ta, C.lane, va); tr_store(Tb, C.lane, vb); }
            }
        }
    } SEAM(3);
    if (C.nb != 256) { if (IN(4)) { ya_transpose(C); } SEAM(4); }
    if (IN(5)) {
        EpiP5C E{(const unsigned char*)(ws + WS_GA), (const unsigned char*)(ws + WS_GB), (bf16*)(ws + WS_MM)};
        if (C.nb == 256) {
            pg8::SchedP5a Sa{(const char*)(ws + WS_YAT), (const char*)(ws + WS_WAT), C.bid}; pg8::SchedP5b Sb{(const char*)(ws + WS_YB), (const char*)(ws + WS_WBT), C.bid};
            pg8::Unit ub; Sb.next(0, ub);
            f32x4 acc[2][2][4][2];
            pg8::gemm_phase_acc<EpiP5C, pg8::SchedP5a, false, false, false, 1, true>(C.lds, HW, Sa, E, acc, &ub, HW, (size_t)M * 2);
            pg8::gemm_phase_acc<EpiP5C, pg8::SchedP5b, false, false, false, 2, false>(C.lds, HW, Sb, E, acc);
        } else {
            pg8::SchedP5 S{(const char*)(ws + WS_YA), (const char*)(ws + WS_WAT), (const char*)(ws + WS_YB), (const char*)(ws + WS_WBT), C.nb, C.bid};
            pg8::gemm_phase(C.lds, HW, S, E);
        }
    } SEAM(5);
    if (IN(6)) {
        pg8::SchedStd S{(const char*)(ws + WS_MM), (const char*)(ws + WS_WOUTT), D, 64, 4, C.nb, C.bid, 0};
        EpiOutFused E{C.in[IN_X], (const float*)(ws + WS_MOD), (bf16*)(ws + WS_XNEW), (const float*)(ws + WS_GRT), (float*)(ws + WS_UPART), (float*)(ws + WS_SSQP)};
        pg8::gemm_phase<EpiOutFused, pg8::SchedStd, false, true>(C.lds, D, S, E);
    } SEAM(6);
    if (IN(8)) { p7_phase(C); } SEAM(8);
    if (IN(9)) {
        pg8::SchedStd S{(const char*)(ws + WS_XIN), (const char*)(ws + WS_W1T), D / 2, 128, 16, C.nb, C.bid, (size_t)4096 * D};
        pg8::Epi<K0<EpiH>> E{{EpiH{(unsigned char*)(ws + WS_HB)}}};
        pg8::gemm_phase<pg8::Epi<K0<EpiH>>, pg8::SchedStd, true, false, true>(C.lds, D / 2, S, E);
    } SEAM(9);
    if (IN(10)) {
        pg8::SchedStd S{(const char*)(ws + WS_HB), (const char*)(ws + WS_W2T), DFF / 2, 128, 4, C.nb, C.bid, (size_t)1024 * DFF};
        EpiY2 E{(const float*)(ws + WS_SELG), (const float*)(ws + WS_MOD), (unsigned char*)(ws + WS_YBUF)};
        pg8::gemm_phase<EpiY2, pg8::SchedStd, true>(C.lds, DFF / 2, S, E);
    } SEAM(10);
    if (IN(11)) { p10_phase(C); }
#undef IN
#undef SEAM
}

extern "C" void kernel_launch(void* const* d_in, const int* in_sizes, int n_in, void* d_out, int out_size, void* d_ws, size_t ws_size, hipStream_t stream) {
    static int grid = 0;
    if (grid == 0) {
        if (n_in != 30 || in_sizes[0] != M * D || out_size != M * D || ws_size < WS_END) { fprintf(stderr, "kernel_launch: unexpected shapes: n_in %d in0 %d out %d ws %zu (need %zu)\n", n_in, n_in > 0 ? in_sizes[0] : -1, out_size, ws_size, (size_t)WS_END); grid = -1; return; }
        int dev = 0, cus = 0, per_cu = 0;
        if (hipGetDevice(&dev) != hipSuccess || hipDeviceGetAttribute(&cus, hipDeviceAttributeMultiprocessorCount, dev) != hipSuccess) { grid = -1; return; }
        if (hipFuncSetAttribute((const void*)mk_fwd, hipFuncAttributeMaxDynamicSharedMemorySize, LDS_BYTES) != hipSuccess) { fprintf(stderr, "kernel_launch: hipFuncSetAttribute failed\n"); grid = -1; return; }
        if (hipOccupancyMaxActiveBlocksPerMultiprocessor(&per_cu, (const void*)mk_fwd, NT, LDS_BYTES) != hipSuccess || per_cu < 1) { fprintf(stderr, "kernel_launch: occupancy query says %d\n", per_cu); per_cu = 1; }
        (void)hipGetLastError();
        grid = cus;
        if (grid != 256) fprintf(stderr, "kernel_launch: built for a 256-CU device (the fused output-projection epilogue needs one 256x256 unit per workgroup); got %d CUs\n", grid);
    }
    if (grid < 0) return;
    if (hipMemsetAsync((char*)d_ws + WS_CTL, 0, CTL_ZERO_BYTES, stream) != hipSuccess) { fprintf(stderr, "kernel_launch: memset failed\n"); return; }
    Args a{};
    for (int i = 0; i < 30; ++i) a.in[i] = (const float*)d_in[i];
    a.out = (float*)d_out; a.ws = (unsigned char*)d_ws;
    if (N_LAUNCHES == NPH) {
        for (int li = 0; li < NPH; ++li) { a.ph_lo = li; a.ph_hi = li + 1; a.li = 0;
            for (int rep = 0; rep < (((DUP_MASK >> li) & 1) ? 2 : 1); ++rep) { a.sub = (rep == 0 && ((DUP_MASK >> li) & 1)) ? DUP_SUB : 0; hipLaunchKernelGGL(mk_fwd, dim3(grid), dim3(NT), LDS_BYTES, stream, a); } }
    } else {
        a.ph_lo = 0; a.ph_hi = NPH; a.li = 0;
        hipLaunchKernelGGL(mk_fwd, dim3(grid), dim3(NT), LDS_BYTES, stream, a);
    }
}
```
